# Optimizing an MI355X kernel written in HIP

```python
import math, functools
import jax, jax.numpy as jnp
from jax import lax
import numpy as np

D_MODEL = 1024
BATCH = 4
SEQ = 4096
DEPTH = 2

GRID_W = 64
CTX_LEN = 256
N_ADA = 9
FF_DIM = 2816
EPS = 1e-6
A_HEADS = 4
A_DK = 128
A_DV = 128
A_DIM = A_HEADS * A_DK
A_CHUNK = 32
B_HEADS = 8
B_HEADDIM = 64
B_DIM = B_HEADS * B_HEADDIM
B_GROUPS = 2
B_STATE = 128
B_CONV = 3
B_CHUNK = 128
B_XBC = B_DIM + 2 * B_GROUPS * B_STATE
EVEN_SPLITS = (A_DIM, A_DIM, 2 * A_DIM, A_DIM, B_DIM, B_XBC, 2 * B_HEADS)
EVEN_IN = A_DIM * 5 + B_DIM + B_XBC + 2 * B_HEADS
EVEN_MIX = A_DIM + B_DIM
C_HEAD = 64
C_HEADS = D_MODEL // C_HEAD
DECAY_LORA = 64
AAA_LORA = 64
GATE_LORA = 128
LNX_EPS = 64e-5
N_EVEN = (DEPTH + 1) // 2
N_ODD = DEPTH // 2

kernel_name = 'hybrid_hgrn2_ssd_rwkv7_macaron_prefix'


def rmsnorm(x, g, eps=EPS):
    xf = x.astype(jnp.float32)
    y = xf * lax.rsqrt(jnp.mean(xf * xf, axis=-1, keepdims=True) + eps)
    return y.astype(x.dtype) * g


def swiglu(h, wi, wo):
    gt, up = jnp.split(h @ wi, 2, axis=-1)
    return (jax.nn.silu(gt) * up) @ wo


def macaron_half(xs, m, slot, g, wi, wo):
    h = rmsnorm(xs, g) * (1.0 + m[3 * slot + 1]) + m[3 * slot]
    return xs + 0.5 * m[3 * slot + 2] * swiglu(h, wi, wo)


def flip_t(z):
    return jnp.flip(z, axis=1)


def dwconv_centred(u, w, b):
    kw = w.shape[0]
    half = kw // 2
    t = u.shape[1]
    up = jnp.pad(u, ((0, 0), (half, half), (0, 0)))
    return sum(w[j] * up[:, j:j + t] for j in range(kw)) + b


def shift_grid(h):
    bsz, t, ch = h.shape
    rows = t // GRID_W
    q = ch // 4
    g = h.reshape(bsz, rows, GRID_W, ch)
    left = jnp.pad(g[:, :, :-1, :q], ((0, 0), (0, 0), (1, 0), (0, 0)))
    right = jnp.pad(g[:, :, 1:, q:2 * q], ((0, 0), (0, 0), (0, 1), (0, 0)))
    up = jnp.pad(g[:, :-1, :, 2 * q:3 * q], ((0, 0), (1, 0), (0, 0), (0, 0)))
    down = jnp.pad(g[:, 1:, :, 3 * q:], ((0, 0), (0, 1), (0, 0), (0, 0)))
    return jnp.concatenate([left, right, up, down], axis=-1).reshape(bsz, t, ch)


def shift_seq(h):
    ch = h.shape[-1]
    prev = jnp.pad(h[:, :-1], ((0, 0), (1, 0), (0, 0)))
    nxt = jnp.pad(h[:, 1:], ((0, 0), (0, 1), (0, 0)))
    from_prev = (jnp.arange(ch) // (ch // 4)) % 2 == 0
    return jnp.where(from_prev, prev, nxt)


def hgrn2_chunk_scan(q, k, v, logf, s0, with_output):
    f32 = jnp.float32
    bsz, t, h, dk = k.shape
    dv = v.shape[-1]
    L = A_CHUNK
    nc = t // L
    k = k.astype(f32).reshape(bsz, nc, L, h, dk)
    v = v.astype(f32).reshape(bsz, nc, L, h, dv)
    bcum = jnp.cumsum(logf.astype(f32).reshape(bsz, nc, L, h, dk), axis=2)
    blast = bcum[:, :, -1]
    ds = jnp.einsum('bclhk,bclhv->bchkv', k * jnp.exp(blast[:, :, None] - bcum), v)

    def step(s, inp):
        dec, d = inp
        return dec[..., None] * s + d, s

    s_fin, s_start = lax.scan(step, s0, (jnp.moveaxis(jnp.exp(blast), 1, 0), jnp.moveaxis(ds, 1, 0)))
    if not with_output:
        return None, s_fin
    s_start = jnp.moveaxis(s_start, 0, 1)
    q = q.astype(f32).reshape(bsz, nc, L, h, dk)
    bref = bcum[:, :, L // 2 - 1:L // 2]
    scores = jnp.einsum('bclhk,bcshk->bchls', q * jnp.exp(bcum - bref), k * jnp.exp(bref - bcum))
    upto = jnp.tril(jnp.ones((L, L), bool))
    scores = jnp.where(upto, scores, 0.0)
    o = (jnp.einsum('bchls,bcshv->bclhv', scores, v)
         + jnp.einsum('bclhk,bchkv->bclhv', q * jnp.exp(bcum), s_start))
    return o.reshape(bsz, t, h, dv), s_fin


def ssd_chunk_scan(x, dt, bm, cm, s0, with_output, a):
    f32 = jnp.float32
    bsz, t, g, hg, p = x.shape
    n = bm.shape[-1]
    L = B_CHUNK
    nc = t // L
    x = x.astype(f32).reshape(bsz, nc, L, g, hg, p)
    dt = dt.astype(f32).reshape(bsz, nc, L, g, hg)
    bm = bm.astype(f32).reshape(bsz, nc, L, g, n)
    cm = cm.astype(f32).reshape(bsz, nc, L, g, n)
    acum = jnp.cumsum(dt * a, axis=2)
    alast = acum[:, :, -1]
    states = jnp.einsum('bclgn,bclgh,bclghp->bcghpn', bm, jnp.exp(alast[:, :, None] - acum) * dt, x)

    def step(s, inp):
        dec, d = inp
        return dec[..., None, None] * s + d, s

    s_fin, s_start = lax.scan(step, s0, (jnp.moveaxis(jnp.exp(alast), 1, 0), jnp.moveaxis(states, 1, 0)))
    if not with_output:
        return None, s_fin
    s_start = jnp.moveaxis(s_start, 0, 1)
    seg = acum[:, :, :, None] - acum[:, :, None, :]
    upto = jnp.tril(jnp.ones((L, L), bool))[:, :, None, None]
    lmat = jnp.exp(jnp.where(upto, seg, -jnp.inf))
    cb = jnp.einsum('bclgn,bcsgn->bclsg', cm, bm)
    y = (jnp.einsum('bclsg,bclsgh,bcsgh,bcsghp->bclghp', cb, lmat, dt, x)
         + jnp.einsum('bclgn,bcghpn,bclgh->bclghp', cm, s_start, jnp.exp(acum)))
    return y.reshape(bsz, t, g, hg, p), s_fin


def rwkv7_scan(r, w, k, v, a, b, s0, with_output):
    f32 = jnp.float32

    def tm(z):
        return jnp.moveaxis(z.astype(f32), 1, 0)

    def update(s, w_t, k_t, v_t, a_t, b_t):
        sa = jnp.einsum('bhij,bhj->bhi', s, a_t)
        return s * w_t[:, :, None, :] + sa[..., None] * b_t[:, :, None, :] + v_t[..., None] * k_t[:, :, None, :]

    if with_output:
        def step(s, inp):
            r_t, w_t, k_t, v_t, a_t, b_t = inp
            s = update(s, w_t, k_t, v_t, a_t, b_t)
            return s, jnp.einsum('bhij,bhj->bhi', s, r_t)
        s_fin, y = lax.scan(step, s0, (tm(r), tm(w), tm(k), tm(v), tm(a), tm(b)))
        return jnp.moveaxis(y, 0, 1), s_fin

    def step_state(s, inp):
        return update(s, *inp), None
    s_fin, _ = lax.scan(step_state, s0, (tm(w), tm(k), tm(v), tm(a), tm(b)))
    return None, s_fin


def prefix_scan(scan_fn, ctx_in, lat_in, s0, need_ctx_out, reverse):
    if reverse:
        ctx_in = [flip_t(z) for z in ctx_in]
        lat_in = [flip_t(z) for z in lat_in]
    y_ctx, s_ctx = scan_fn(*ctx_in, s0, need_ctx_out)
    y_lat, _ = scan_fn(*lat_in, s_ctx, True)
    if reverse:
        y_lat = flip_t(y_lat)
        y_ctx = None if y_ctx is None else flip_t(y_ctx)
    return y_ctx, y_lat


def even_mixer(h_lat, h_ctx, in_w, out_w, lb, hgrn_g, conv_w, conv_b, dt_bias, a_log, d_skip, ssd_g, need_ctx_out):
    f32 = jnp.float32
    cuts = [int(v) for v in np.cumsum(EVEN_SPLITS)[:-1]]
    hg = B_HEADS // B_GROUPS

    def features(h):
        bsz, t, _ = h.shape
        q, i, f, g, z, xbc, dt = jnp.split(h @ in_w, cuts, axis=-1)
        f = lb + (1.0 - lb) * jax.nn.sigmoid(f.astype(f32).reshape(bsz, t, 2, A_HEADS, A_DK))
        xbc = jax.nn.silu(dwconv_centred(xbc, conv_w, conv_b))
        xs, bm, cm = jnp.split(xbc, [B_DIM, B_DIM + B_GROUPS * B_STATE], axis=-1)
        return dict(
            q=jax.nn.silu(q).reshape(bsz, t, A_HEADS, A_DK),
            i=i.reshape(bsz, t, A_HEADS, A_DV),
            k=1.0 - f, logf=jnp.log(f), g=g, z=z,
            x=xs.reshape(bsz, t, B_GROUPS, hg, B_HEADDIM),
            b=bm.reshape(bsz, t, B_GROUPS, B_STATE),
            c=cm.reshape(bsz, t, B_GROUPS, B_STATE),
            dt=jax.nn.softplus(dt.astype(f32).reshape(bsz, t, 2, B_GROUPS, hg)
                               + dt_bias.astype(f32).reshape(2, B_GROUPS, hg)))

    fc, fl = features(h_ctx), features(h_lat)
    bsz = h_lat.shape[0]
    a = -jnp.exp(a_log.astype(f32)).reshape(2, B_GROUPS, hg)
    s0_a = jnp.zeros((bsz, A_HEADS, A_DK, A_DV), f32)
    s0_b = jnp.zeros((bsz, B_GROUPS, hg, B_HEADDIM, B_STATE), f32)
    ya, yb = [], []
    for d in range(2):
        ya.append(prefix_scan(hgrn2_chunk_scan,
                              [fc['q'], fc['k'][:, :, d], fc['i'], fc['logf'][:, :, d]],
                              [fl['q'], fl['k'][:, :, d], fl['i'], fl['logf'][:, :, d]],
                              s0_a, need_ctx_out, d == 1))
        yb.append(prefix_scan(functools.partial(ssd_chunk_scan, a=a[d]),
                              [fc['x'], fc['dt'][:, :, d], fc['b'], fc['c']],
                              [fl['x'], fl['dt'][:, :, d], fl['b'], fl['c']],
                              s0_b, need_ctx_out, d == 1))

    def finish(fe, oa, ob, dtype):
        bsz_, t = oa.shape[:2]
        oa = rmsnorm(oa, hgrn_g).reshape(bsz_, t, A_DIM) * jax.nn.silu(fe['g'].astype(f32))
        ob = ob + d_skip.astype(f32).reshape(B_GROUPS, hg, 1) * fe['x']
        ob = ob.reshape(bsz_, t, B_GROUPS, hg * B_HEADDIM) * jax.nn.silu(fe['z'].astype(f32)).reshape(bsz_, t, B_GROUPS, hg * B_HEADDIM)
        ob = rmsnorm(ob, ssd_g.reshape(B_GROUPS, hg * B_HEADDIM)).reshape(bsz_, t, B_DIM)
        return jnp.concatenate([oa, ob], axis=-1).astype(dtype) @ out_w

    y_lat = finish(fl, ya[0][1] + ya[1][1], yb[0][1] + yb[1][1], h_lat.dtype)
    y_ctx = finish(fc, ya[0][0] + ya[1][0], yb[0][0] + yb[1][0], h_ctx.dtype) if need_ctx_out else None
    return y_lat, y_ctx


def odd_mixer(h_lat, h_ctx, x_mix, wr, wk, wv, wo, w0, w1, w2, a0, a1, a2, g1, g2, k_k, k_a, r_k,
              ln_w, ln_b, need_ctx_out):
    f32 = jnp.float32

    def heads(z):
        return z.reshape(*z.shape[:-1], C_HEADS, C_HEAD)

    def features(h, h_shift):
        xx = h_shift - h
        xr, xw, xk, xv, xa, xg = [h + xx * x_mix[j] for j in range(6)]
        k = (xk @ wk).astype(f32)
        zw = w0[:, None, None].astype(f32) + jnp.einsum(
            'dbtr,drc->dbtc', jnp.tanh(jnp.einsum('btc,dcr->dbtr', xw, w1)), w2).astype(f32)
        za = a0[:, None, None] + jnp.einsum('dbtr,drc->dbtc', jnp.einsum('btc,dcr->dbtr', xa, a1), a2)
        a = jax.nn.sigmoid(za.astype(f32))
        kk = heads(k * k_k)
        kk = kk * lax.rsqrt(jnp.maximum(jnp.sum(kk * kk, axis=-1, keepdims=True), 1e-24))
        return dict(r=heads(xr @ wr), v=heads(xv @ wv),
                    g=jax.nn.sigmoid(xg @ g1) @ g2,
                    decay=heads(jnp.exp(-jnp.exp(-jax.nn.softplus(-zw) - 0.5))),
                    k=heads(k * (1.0 + (a - 1.0) * k_a)), a=heads(a), kk=kk)

    fc = features(h_ctx, shift_seq(h_ctx))
    fl = features(h_lat, shift_grid(h_lat))
    bsz = h_lat.shape[0]
    s0 = jnp.zeros((bsz, C_HEADS, C_HEAD, C_HEAD), f32)

    def scan_inputs(fe, d):
        return [fe['r'], fe['decay'][d], fe['k'][d], fe['v'], -fe['kk'], fe['kk'] * fe['a'][d]]

    outs = [prefix_scan(rwkv7_scan, scan_inputs(fc, d), scan_inputs(fl, d), s0, need_ctx_out, d == 1)
            for d in range(2)]

    def finish(fe, y, dtype):
        bsz_, t = y.shape[:2]
        mu = jnp.mean(y, axis=-1, keepdims=True)
        var = jnp.mean(jnp.square(y - mu), axis=-1, keepdims=True)
        yn = ((y - mu) * lax.rsqrt(var + LNX_EPS)).reshape(bsz_, t, D_MODEL) * ln_w + ln_b
        bonus = jnp.sum(fe['r'].astype(f32)[None] * fe['k'] * r_k, axis=-1, keepdims=True).sum(0) * fe['v']
        yn = yn + bonus.reshape(bsz_, t, D_MODEL)
        return (yn * fe['g']).astype(dtype) @ wo

    y_lat = finish(fl, outs[0][1] + outs[1][1], h_lat.dtype)
    y_ctx = finish(fc, outs[0][0] + outs[1][0], h_ctx.dtype) if need_ctx_out else None
    return y_lat, y_ctx


def setup_inputs(seed: int = 0) -> dict:
    key = jax.random.key(seed)
    ks = iter(jax.random.split(key, 64))
    f32 = jnp.float32

    def nrm(shape, std):
        return std * jax.random.normal(next(ks), shape, f32)

    def gain(shape):
        return 1.0 + nrm(shape, 0.02)

    def unif(shape, lo, hi):
        return jax.random.uniform(next(ks), shape, f32, lo, hi)

    D = D_MODEL
    dt0 = jnp.exp(unif((N_EVEN, 2, B_HEADS), math.log(1e-3), math.log(1e-1)))
    return {
        'x': nrm((BATCH, SEQ, D), 1.0),
        'c': nrm((BATCH, D), 1.0),
        'ctx': nrm((BATCH, CTX_LEN, D), 1.0),
        'c_ctx': nrm((D,), 1.0),
        'ada_w': nrm((DEPTH, D, N_ADA * D), 0.5 * D ** -0.5),
        'ada_b': nrm((DEPTH, N_ADA * D), 0.01),
        'norm_g': gain((DEPTH, 3, D)),
        'ffn_wi': nrm((DEPTH, 2, D, 2 * FF_DIM), D ** -0.5),
        'ffn_wo': nrm((DEPTH, 2, FF_DIM, D), FF_DIM ** -0.5),
        'final_g': gain((D,)),
        'hgrn_lb_logits': nrm((DEPTH + 1, 2, A_DIM), 0.1),
        'ev_in_w': nrm((N_EVEN, D, EVEN_IN), D ** -0.5),
        'ev_out_w': nrm((N_EVEN, EVEN_MIX, D), EVEN_MIX ** -0.5),
        'hgrn_norm_g': gain((N_EVEN, A_DV)),
        'ssd_conv_w': nrm((N_EVEN, B_CONV, B_XBC), B_CONV ** -0.5),
        'ssd_conv_b': nrm((N_EVEN, B_XBC), 0.01),
        'ssd_dt_bias': dt0 + jnp.log(-jnp.expm1(-dt0)),
        'ssd_a_log': jnp.log(unif((N_EVEN, 2, B_HEADS), 1.0, 16.0)),
        'ssd_d': 1.0 + nrm((N_EVEN, B_HEADS), 0.1),
        'ssd_norm_g': gain((N_EVEN, B_DIM)),
        'rw_x_mix': unif((N_ODD, 6, D), 0.0, 1.0),
        'rw_wr': nrm((N_ODD, D, D), D ** -0.5),
        'rw_wk': nrm((N_ODD, D, D), D ** -0.5),
        'rw_wv': nrm((N_ODD, D, D), D ** -0.5),
        'rw_wo': nrm((N_ODD, D, D), D ** -0.5),
        'rw_w0': unif((N_ODD, 2, D), -6.0, 1.0),
        'rw_w1': nrm((N_ODD, 2, D, DECAY_LORA), D ** -0.5),
        'rw_w2': nrm((N_ODD, 2, DECAY_LORA, D), 0.5 * DECAY_LORA ** -0.5),
        'rw_a0': nrm((N_ODD, 2, D), 0.1),
        'rw_a1': nrm((N_ODD, 2, D, AAA_LORA), D ** -0.5),
        'rw_a2': nrm((N_ODD, 2, AAA_LORA, D), 0.5 * AAA_LORA ** -0.5),
        'rw_g1': nrm((N_ODD, D, GATE_LORA), D ** -0.5),
        'rw_g2': nrm((N_ODD, GATE_LORA, D), GATE_LORA ** -0.5),
        'rw_k_k': 0.85 + nrm((N_ODD, D), 0.05),
        'rw_k_a': 1.0 + nrm((N_ODD, D), 0.05),
        'rw_r_k': nrm((N_ODD, C_HEADS, C_HEAD), 0.1),
        'rw_ln_w': gain((N_ODD, D)),
        'rw_ln_b': nrm((N_ODD, D), 0.01),
    }


def reference(x, c, ctx, c_ctx, ada_w, ada_b, norm_g, ffn_wi, ffn_wo, final_g, hgrn_lb_logits,
              ev_in_w, ev_out_w, hgrn_norm_g, ssd_conv_w, ssd_conv_b, ssd_dt_bias, ssd_a_log, ssd_d,
              ssd_norm_g, rw_x_mix, rw_wr, rw_wk, rw_wv, rw_wo, rw_w0, rw_w1, rw_w2, rw_a0, rw_a1,
              rw_a2, rw_g1, rw_g2, rw_k_k, rw_k_a, rw_r_k, rw_ln_w, rw_ln_b):
    f32 = jnp.float32
    bsz = x.shape[0]
    lb_all = jnp.cumsum(jax.nn.softmax(hgrn_lb_logits.astype(f32), axis=0), axis=0)
    sc = jax.nn.silu(c)
    scc = jax.nn.silu(c_ctx)
    x_lat, x_ctx = x, ctx
    for layer in range(DEPTH):
        last = layer == DEPTH - 1
        m_lat = (sc @ ada_w[layer] + ada_b[layer]).reshape(bsz, N_ADA, D_MODEL).transpose(1, 0, 2)[:, :, None, :]
        m_ctx = (scc @ ada_w[layer] + ada_b[layer]).reshape(N_ADA, D_MODEL)
        g = norm_g[layer]
        x_lat = macaron_half(x_lat, m_lat, 0, g[0], ffn_wi[layer, 0], ffn_wo[layer, 0])
        x_ctx = macaron_half(x_ctx, m_ctx, 0, g[0], ffn_wi[layer, 0], ffn_wo[layer, 0])
        h_lat = rmsnorm(x_lat, g[1]) * (1.0 + m_lat[4]) + m_lat[3]
        h_ctx = rmsnorm(x_ctx, g[1]) * (1.0 + m_ctx[4]) + m_ctx[3]
        if layer % 2 == 0:
            e = layer // 2
            y_lat, y_ctx = even_mixer(h_lat, h_ctx, ev_in_w[e], ev_out_w[e],
                                      lb_all[layer].reshape(2, A_HEADS, A_DK), hgrn_norm_g[e],
                                      ssd_conv_w[e], ssd_conv_b[e], ssd_dt_bias[e], ssd_a_log[e],
                                      ssd_d[e], ssd_norm_g[e], not last)
        else:
            o = layer // 2
            y_lat, y_ctx = odd_mixer(h_lat, h_ctx, rw_x_mix[o], rw_wr[o], rw_wk[o], rw_wv[o], rw_wo[o],
                                     rw_w0[o], rw_w1[o], rw_w2[o], rw_a0[o], rw_a1[o], rw_a2[o],
                                     rw_g1[o], rw_g2[o], rw_k_k[o], rw_k_a[o], rw_r_k[o],
                                     rw_ln_w[o], rw_ln_b[o], not last)
        x_lat = x_lat + m_lat[5] * y_lat
        x_lat = macaron_half(x_lat, m_lat, 2, g[2], ffn_wi[layer, 1], ffn_wo[layer, 1])
        if not last:
            x_ctx = x_ctx + m_ctx[5] * y_ctx
            x_ctx = macaron_half(x_ctx, m_ctx, 2, g[2], ffn_wi[layer, 1], ffn_wo[layer, 1])
    return rmsnorm(x_lat, final_g)
```

```cpp
#include <hip/hip_runtime.h>
#include <hip/hip_cooperative_groups.h>
#include <cstdio>
namespace cg = cooperative_groups;

#define DEV __device__ __forceinline__
typedef unsigned short u16;
typedef __attribute__((ext_vector_type(8))) short bf16x8;
typedef __attribute__((ext_vector_type(4))) short bf16x4;
typedef __attribute__((ext_vector_type(2))) short bf16x2;
typedef __attribute__((ext_vector_type(4))) float f32x4;

constexpr int D = 1024;
constexpr int MLAT = 16384;
constexpr int MCTX = 1024;
constexpr int MTOT = 17408;
constexpr int FF = 2816;
constexpr int PLD = 4112;
constexpr int LLD = 384;

constexpr size_t OFF_X = 0;
constexpr size_t OFF_MOD = 71303168;
constexpr size_t OFF_W = OFF_MOD + 368640;
constexpr size_t W_WI0 = 0, W_WI1 = 11534336, W_WO0 = 23068672, W_WO1 = 28835840, W_MIX = 34603008;
constexpr size_t W_IN = W_MIX, W_OUT = W_MIX + 8650752;
constexpr size_t W_R = W_MIX, W_K = W_MIX + 2097152, W_V = W_MIX + 4194304;
constexpr size_t W_W1 = W_MIX + 6291456, W_A1 = W_W1 + 262144, W_G1 = W_A1 + 262144;
constexpr size_t W_O = W_G1 + 262144;
constexpr size_t W_W2 = W_O + 2097152, W_A2 = W_W2 + 262144, W_G2 = W_A2 + 262144;
constexpr size_t WSIZE = 46000128;
constexpr size_t OFF_S = OFF_W + WSIZE;
constexpr size_t SZ_H = 35651584;
constexpr size_t S_H = 0;
constexpr size_t S_ACT = SZ_H;
constexpr size_t S_O1 = SZ_H, S_P = 2 * SZ_H;
constexpr size_t S_Y1 = SZ_H, S_R = 2 * SZ_H, S_K = 3 * SZ_H, S_V = 4 * SZ_H, S_G = 5 * SZ_H;
constexpr size_t S_LORA = 6 * SZ_H;
constexpr size_t S_BON = S_LORA + 13369344;
constexpr size_t OFF_BAR = OFF_W + 45400064;
constexpr size_t OFF_LBT = OFF_BAR + 16384;
constexpr size_t S_PART = 4 * SZ_H;
constexpr size_t S_F = 2 * SZ_H + 143163392;

struct Params {
  const float* in[38];
  float* out;
  char* ws;
};

enum { I_X = 0, I_C, I_CTX, I_CCTX, I_ADAW, I_ADAB, I_NORMG, I_WI, I_WO, I_FINALG, I_LB, I_EVIN, I_EVOUT,
       I_HGRNG, I_CONVW, I_CONVB, I_DTB, I_ALOG, I_SSDD, I_SSDG, I_XMIX, I_WR, I_WK, I_WV, I_WOO, I_W0, I_W1,
       I_W2, I_A0, I_A1, I_A2, I_G1, I_G2, I_KK, I_KA, I_RK, I_LNW, I_LNB };

DEV float bf2f(short v) { return __uint_as_float(((unsigned)(unsigned short)v) << 16); }
DEV short f2bf(float f) { return __builtin_bit_cast(short, (__bf16)f); }
DEV float sigm(float x) { return __builtin_amdgcn_rcpf(1.0f + __expf(-x)); }
DEV float silu(float x) { return x * sigm(x); }

template <int CTRL>
DEV float dppf(float v) {
  return __int_as_float(__builtin_amdgcn_update_dpp(0, __float_as_int(v), CTRL, 0xF, 0xF, true));
}
DEV float red4(float v) { v += dppf<0xB1>(v); v += dppf<0x4E>(v); return v; }
DEV float red8(float v) { v = red4(v); v += dppf<0x141>(v); return v; }
DEV float red16(float v) { v = red8(v); v += dppf<0x140>(v); return v; }
DEV float red64(float v) {
  v = red16(v);
  v += __shfl_xor(v, 16);
  v += __shfl_xor(v, 32);
  return v;
}


#define XB_TMO      128
#define XB_XCNT(j)  (256  + 64 * (j))
#define XB_XSUB(j)  (1280 + 64 * (j))
#define XB_XGEN(j)  (2304 + 64 * (j))
#define XB_TOP      3328
#define XB_TOPGEN   3392
#define XCD_BAR_WORDS 3456
#define XB_SPIN_CAP (1u << 20)
DEV unsigned xb_ld(unsigned* p) { return __hip_atomic_load(p, __ATOMIC_RELAXED, __HIP_MEMORY_SCOPE_AGENT); }
DEV unsigned xb_add(unsigned* p, unsigned v) { return __hip_atomic_fetch_add(p, v, __ATOMIC_RELAXED, __HIP_MEMORY_SCOPE_AGENT); }
DEV unsigned xb_xcc_id() { return (unsigned)__builtin_amdgcn_s_getreg((3 << 11) | 20) & 0xFu; }
#define XB_SPIN(cond, bar) do { unsigned _sp = 0; while (cond) { __builtin_amdgcn_s_sleep(1); \
    if ((++_sp & 255u) == 0u) { if (xb_ld(&(bar)[XB_TMO])) break; if (_sp > XB_SPIN_CAP) { atomicAdd(&(bar)[XB_TMO], 1u); break; } } } } while (0)
struct XcdBarrier { unsigned* bar; unsigned x; unsigned nloc; unsigned nx; };
DEV XcdBarrier xcd_barrier_post(unsigned* bar) {
  XcdBarrier b; b.bar = bar; b.x = xb_xcc_id(); b.nloc = 0u; b.nx = 0u;
  if (threadIdx.x == 0) (void)xb_add(&bar[XB_XCNT(b.x)], 1u);
  return b;
}
DEV void xcd_barrier_complete(unsigned* bar, unsigned x, unsigned& nloc, unsigned& nx) {
  const unsigned G = gridDim.x;
  unsigned sum, cnt, mine, sp = 0u;
  for (;;) {
    sum = 0u; cnt = 0u; mine = 0u;
#pragma unroll
    for (unsigned j = 0; j < 16; ++j) { const unsigned c = xb_ld(&bar[XB_XCNT(j)]); sum += c; cnt += (c > 0u) ? 1u : 0u; mine = (j == x) ? c : mine; }
    if (sum == G) break;
    __builtin_amdgcn_s_sleep(1);
    if ((++sp & 255u) == 0u) { if (xb_ld(&bar[XB_TMO])) break; if (sp > XB_SPIN_CAP) { atomicAdd(&bar[XB_TMO], 1u); break; } }
  }
  nloc = mine > 0u ? mine : 1u; nx = cnt > 0u ? cnt : 1u;
}
DEV void xcd_barrier(XcdBarrier& b) {
  asm volatile("s_waitcnt vmcnt(0)" ::: "memory");
  __syncthreads();
  if (threadIdx.x == 0) {
    unsigned* bar = b.bar;
    __builtin_amdgcn_s_waitcnt(0);
    if (b.nloc == 0u) xcd_barrier_complete(bar, b.x, b.nloc, b.nx);
    const unsigned nloc = b.nloc, nx = b.nx;
    const unsigned old = xb_add(&bar[XB_XSUB(b.x)], 1u);
    const unsigned gen = old / nloc;
    if (old + 1u == (gen + 1u) * nloc) {
      __builtin_amdgcn_fence(__ATOMIC_RELEASE, "agent");
      asm volatile("s_waitcnt vmcnt(0)" ::: "memory");
      const unsigned og = xb_add(&bar[XB_TOP], 1u);
      const unsigned tg = og / nx;
      if (og + 1u == (tg + 1u) * nx) xb_add(&bar[XB_TOPGEN], 1u);
      else XB_SPIN(xb_ld(&bar[XB_TOPGEN]) == tg, bar);
      __builtin_amdgcn_fence(__ATOMIC_ACQUIRE, "agent");
      xb_add(&bar[XB_XGEN(b.x)], 1u);
      asm volatile("s_waitcnt vmcnt(0)" ::: "memory");
    } else {
      XB_SPIN(xb_ld(&bar[XB_XGEN(b.x)]) == gen, bar);
      __builtin_amdgcn_fence(__ATOMIC_ACQUIRE, "agent");
      asm volatile("s_waitcnt vmcnt(0)" ::: "memory");
    }
  }
  __syncthreads();
}

DEV const float* xrow_ptr(const float* lat, const float* ctx, int row) {
  return row < MLAT ? lat + (size_t)row * D : ctx + (size_t)(row - MLAT) * D;
}
DEV int mod_idx(int row) { return row < MLAT ? (row >> 12) : 4; }

struct APlain {
  const u16* A; int lda;
  DEV bf16x8 operator()(int row, int k, int tn) const { return *(const bf16x8*)(A + (size_t)row * lda + k); }
};

struct AShift {
  const u16* H; const float* mixbase; int tn_off;
  DEV bf16x8 operator()(int row, int k, int tn0) const {
    const int tn = tn0 + tn_off;
    const int jsel = tn < 24 ? (tn < 8 ? 0 : (tn < 16 ? 2 : 3)) : (tn == 24 ? 1 : (tn == 25 ? 4 : 5));
    const float* mix = mixbase + jsel * D;
    bf16x8 own = *(const bf16x8*)(H + (size_t)row * D + k);
    const int q = k >> 8;
    int nrow; bool valid;
    if (row < MLAT) {
      const int t = row & 4095, cx = t & 63, ry = t >> 6;
      if (q == 0) { valid = cx > 0; nrow = row - 1; }
      else if (q == 1) { valid = cx < 63; nrow = row + 1; }
      else if (q == 2) { valid = ry > 0; nrow = row - 64; }
      else { valid = ry < 63; nrow = row + 64; }
    } else {
      const int t = (row - MLAT) & 255;
      if ((q & 1) == 0) { valid = t > 0; nrow = row - 1; }
      else { valid = t < 255; nrow = row + 1; }
    }
    bf16x8 nb = *(const bf16x8*)(H + (size_t)(valid ? nrow : row) * D + k);
    if (!valid) nb = bf16x8{0, 0, 0, 0, 0, 0, 0, 0};
    const float4 m0 = *(const float4*)(mix + k), m1 = *(const float4*)(mix + k + 4);
    const float mm[8] = {m0.x, m0.y, m0.z, m0.w, m1.x, m1.y, m1.z, m1.w};
    bf16x8 o;
#pragma unroll
    for (int e = 0; e < 8; ++e) {
      const float a = bf2f(own[e]), sft = bf2f(nb[e]);
      o[e] = f2bf(a + (sft - a) * mm[e]);
    }
    return o;
  }
};

DEV float act_apply(float v, int act) {
  if (act == 1) return 2.0f * sigm(2.0f * v) - 1.0f;
  if (act == 2) return sigm(v);
  return v;
}
DEV void store16_bf16(u16* dst, const f32x4 (&a)[4], int act) {
  bf16x8 o0, o1;
#pragma unroll
  for (int j = 0; j < 4; ++j) {
    o0[j] = f2bf(act_apply(a[0][j], act)); o0[4 + j] = f2bf(act_apply(a[1][j], act));
    o1[j] = f2bf(act_apply(a[2][j], act)); o1[4 + j] = f2bf(act_apply(a[3][j], act));
  }
  *(bf16x8*)dst = o0;
  *(bf16x8*)(dst + 8) = o1;
}

struct EpStore {
  u16* C; int ldc; int ncols; int act; int coloff;
  DEV void operator()(f32x4 (&acc)[4][4], int rbase, int cbase, int lane) const {
    const int fr = lane & 15, fq = lane >> 4;
    const int col = cbase + fq * 16;
    if (col < ncols) {
#pragma unroll
      for (int m = 0; m < 4; ++m) {
        const int row = rbase + m * 16 + fr;
        store16_bf16(C + (size_t)row * ldc + coloff + col, acc[m], act);
      }
    }
  }
};

struct EpEvenIn {
  u16* P; const float* lbt;
  DEV void operator()(f32x4 (&acc)[4][4], int rbase, int cbase, int lane) const {
    const int fr = lane & 15, fq = lane >> 4;
    const int col = cbase + fq * 16;
    if (col >= PLD) return;
    const int mode = col < 512 ? 1 : ((col >= 1024 && col < 2048) ? 2 : 0);
    float oml[16];
    if (mode == 2) {
#pragma unroll
      for (int n = 0; n < 4; ++n) {
        const float4 l4 = *(const float4*)(lbt + (col - 1024) + n * 4);
        oml[n * 4 + 0] = 1.0f - l4.x; oml[n * 4 + 1] = 1.0f - l4.y; oml[n * 4 + 2] = 1.0f - l4.z; oml[n * 4 + 3] = 1.0f - l4.w;
      }
    } else {
#pragma unroll
      for (int e = 0; e < 16; ++e) oml[e] = 0.f;
    }
#pragma unroll
    for (int m = 0; m < 4; ++m) {
      const int row = rbase + m * 16 + fr;
      bf16x8 o0, o1;
#pragma unroll
      for (int n = 0; n < 4; ++n)
#pragma unroll
        for (int j = 0; j < 4; ++j) {
          float v = acc[m][n][j];
          if (mode == 1) v = silu(v);
          else if (mode == 2) v = oml[n * 4 + j] * sigm(-v);
          const short h = f2bf(v);
          if (n < 2) o0[n * 4 + j] = h; else o1[(n - 2) * 4 + j] = h;
        }
      *(bf16x8*)(P + (size_t)row * PLD + col) = o0;
      *(bf16x8*)(P + (size_t)row * PLD + col + 8) = o1;
    }
  }
};

struct EpOdd {
  u16* RKV; u16* LORA;
  DEV void operator()(f32x4 (&acc)[4][4], int rbase, int cbase, int lane) const {
    const int fr = lane & 15, fq = lane >> 4;
    const int tn = cbase >> 7;
    if (tn < 24) {
      u16* C = RKV + (size_t)(tn >> 3) * (SZ_H / 2);
      const int col = (cbase & 1023) + fq * 16;
#pragma unroll
      for (int m = 0; m < 4; ++m) store16_bf16(C + (size_t)(rbase + m * 16 + fr) * D + col, acc[m], 0);
    } else {
      const int act = tn == 24 ? 1 : (tn == 25 ? 0 : 2);
      const int col = (tn - 24) * 128 + (cbase & 127) + fq * 16;
#pragma unroll
      for (int m = 0; m < 4; ++m) store16_bf16(LORA + (size_t)(rbase + m * 16 + fr) * LLD + col, acc[m], act);
    }
  }
};

struct EpSwiglu {
  u16* ACT;
  DEV void operator()(f32x4 (&acc)[4][4], int rbase, int cbase, int lane) const {
    const int fr = lane & 15, fq = lane >> 4;
    const int col = (cbase >> 1) + fq * 8;
#pragma unroll
    for (int m = 0; m < 4; ++m) {
      const int row = rbase + m * 16 + fr;
      bf16x8 o;
#pragma unroll
      for (int nn = 0; nn < 2; ++nn)
#pragma unroll
        for (int j = 0; j < 4; ++j) o[nn * 4 + j] = f2bf(silu(acc[m][nn][j]) * acc[m][nn + 2][j]);
      *(bf16x8*)(ACT + (size_t)row * FF + col) = o;
    }
  }
};

struct EpResid {
  const float* xlat; const float* xctx; float* xout; const float* modl; int gidx; float scale;
  DEV void operator()(f32x4 (&acc)[4][4], int rbase, int cbase, int lane) const {
    const int fr = lane & 15, fq = lane >> 4;
    const int col = cbase + fq * 16;
    const float* gate = modl + (size_t)mod_idx(rbase) * 9216 + gidx * 1024 + col;
    float4 gv[4];
#pragma unroll
    for (int n = 0; n < 4; ++n) {
      gv[n] = *(const float4*)(gate + n * 4);
      gv[n].x *= scale; gv[n].y *= scale; gv[n].z *= scale; gv[n].w *= scale;
    }
#pragma unroll
    for (int m = 0; m < 4; ++m) {
      const int row = rbase + m * 16 + fr;
      const float* xi = xrow_ptr(xlat, xctx, row) + col;
      float* xo = xout + (size_t)row * D + col;
#pragma unroll
      for (int n = 0; n < 4; ++n) {
        float4 v = *(const float4*)(xi + n * 4);
        v.x += gv[n].x * acc[m][n][0]; v.y += gv[n].y * acc[m][n][1];
        v.z += gv[n].z * acc[m][n][2]; v.w += gv[n].w * acc[m][n][3];
        *(float4*)(xo + n * 4) = v;
      }
    }
  }
};

struct ATwo {
  const u16* A0; const u16* A1;
  DEV bf16x8 operator()(int row, int k, int tn) const { return *(const bf16x8*)((tn < 8 ? A0 : A1) + (size_t)row * D + k); }
};

struct EpLora {
  u16* LORA;
  DEV void operator()(f32x4 (&acc)[4][4], int rbase, int cbase, int lane) const {
    const int fr = lane & 15, fq = lane >> 4;
    const int tn = cbase >> 7;
    const int act = tn == 0 ? 1 : (tn == 1 ? 0 : 2);
    const int col = cbase + fq * 16;
#pragma unroll
    for (int m = 0; m < 4; ++m) store16_bf16(LORA + (size_t)(rbase + m * 16 + fr) * LLD + col, acc[m], act);
  }
};

DEV void phase_mix(const Params& p, int j0, u16* dst0, int j1, u16* dst1, int nrows) {
  const u16* H = (const u16*)(p.ws + OFF_S + S_H);
  const int lane = threadIdx.x & 63;
  const int gw = blockIdx.x * 4 + (threadIdx.x >> 6), stride = gridDim.x * 4;
  const int q = lane >> 4;
  for (int row = gw; row < nrows; row += stride) {
    int nrow; bool valid;
    if (row < MLAT) {
      const int t = row & 4095, cx = t & 63, ry = t >> 6;
      if (q == 0) { valid = cx > 0; nrow = row - 1; }
      else if (q == 1) { valid = cx < 63; nrow = row + 1; }
      else if (q == 2) { valid = ry > 0; nrow = row - 64; }
      else { valid = ry < 63; nrow = row + 64; }
    } else {
      const int t = (row - MLAT) & 255;
      if ((q & 1) == 0) { valid = t > 0; nrow = row - 1; }
      else { valid = t < 255; nrow = row + 1; }
    }
#pragma unroll
    for (int hh = 0; hh < 2; ++hh) {
      const int c = lane * 16 + hh * 8;
      const bf16x8 own = *(const bf16x8*)(H + (size_t)row * D + c);
      bf16x8 nb = *(const bf16x8*)(H + (size_t)(valid ? nrow : row) * D + c);
      if (!valid) nb = bf16x8{0, 0, 0, 0, 0, 0, 0, 0};
      float m0[8], m1[8];
      *(float4*)(m0) = *(const float4*)(p.in[I_XMIX] + j0 * D + c); *(float4*)(m0 + 4) = *(const float4*)(p.in[I_XMIX] + j0 * D + c + 4);
      bf16x8 o0, o1;
#pragma unroll
      for (int e = 0; e < 8; ++e) {
        const float a = bf2f(own[e]), sft = bf2f(nb[e]);
        o0[e] = f2bf(a + (sft - a) * m0[e]);
      }
      *(bf16x8*)(dst0 + (size_t)row * D + c) = o0;
      if (dst1) {
        *(float4*)(m1) = *(const float4*)(p.in[I_XMIX] + j1 * D + c); *(float4*)(m1 + 4) = *(const float4*)(p.in[I_XMIX] + j1 * D + c + 4);
#pragma unroll
        for (int e = 0; e < 8; ++e) {
          const float a = bf2f(own[e]), sft = bf2f(nb[e]);
          o1[e] = f2bf(a + (sft - a) * m1[e]);
        }
        *(bf16x8*)(dst1 + (size_t)row * D + c) = o1;
      }
    }
  }
}

DEV int keyB(int r) { return (((r >> 4) & 3) << 1) | ((r >> 1) & 1); }

#ifndef GM
#define GM 8
#endif
template <class AL, bool DEEP>
DEV void gemm_kloop(char* smem, const u16* __restrict__ Bt, int ldb, const AL& al, int row0, int col0, int tn,
                    int kt_lo, int nk, f32x4 (&acc)[4][4]) {
  const int tid = threadIdx.x, lane = tid & 63, wave = tid >> 6;
  const int wm = wave >> 1, wn = wave & 1, fr = lane & 15, fq = lane >> 4;
  const int r0 = tid >> 3, c0 = tid & 7;
  const int kB = ((fr >> 2) << 1) | ((fr >> 1) & 1);
#pragma unroll
  for (int m = 0; m < 4; ++m)
#pragma unroll
    for (int n = 0; n < 4; ++n) acc[m][n] = f32x4{0.f, 0.f, 0.f, 0.f};
  bf16x8 ra0[4], rb0[4], ra1[4], rb1[4];
#define GLOAD(RA, RB, kt)                                                                          \
  {                                                                                                \
    const int kk_ = (kt_lo + (kt)) * 64 + c0 * 8;                                                  \
    _Pragma("unroll") for (int i = 0; i < 4; ++i) {                                                \
      RA[i] = al(row0 + r0 + i * 32, kk_, tn);                                                     \
      RB[i] = *(const bf16x8*)(Bt + (size_t)(col0 + r0 + i * 32) * ldb + kk_);                     \
    }                                                                                              \
  }
#define LWRITE(RA, RB, stage)                                                                      \
  {                                                                                                \
    _Pragma("unroll") for (int i = 0; i < 4; ++i) {                                                \
      const int r_ = r0 + i * 32;                                                                  \
      *(bf16x8*)(smem + (stage) * 32768 + r_ * 128 + ((c0 ^ (r_ & 7)) << 4)) = RA[i];             \
      *(bf16x8*)(smem + (stage) * 32768 + 16384 + r_ * 128 + ((c0 ^ keyB(r_)) << 4)) = RB[i];     \
    }                                                                                              \
  }
#define COMPUTE(stage)                                                                             \
  {                                                                                                \
    const char* sa_ = smem + (stage) * 32768;                                                      \
    const char* sb_ = sa_ + 16384;                                                                 \
    _Pragma("unroll") for (int ks = 0; ks < 2; ++ks) {                                             \
      bf16x8 af[4], bfr[4];                                                                        \
      const int c_ = ks * 4 + fq;                                                                  \
      _Pragma("unroll") for (int m = 0; m < 4; ++m)                                                \
        af[m] = *(const bf16x8*)(sa_ + (wm * 64 + m * 16 + fr) * 128 + ((c_ ^ (fr & 7)) << 4));    \
      _Pragma("unroll") for (int n = 0; n < 4; ++n)                                                \
        bfr[n] = *(const bf16x8*)(sb_ + (wn * 64 + (fr >> 2) * 16 + n * 4 + (fr & 3)) * 128 + ((c_ ^ kB) << 4)); \
      _Pragma("unroll") for (int m = 0; m < 4; ++m)                                                \
        _Pragma("unroll") for (int n = 0; n < 4; ++n)                                              \
          acc[m][n] = __builtin_amdgcn_mfma_f32_16x16x32_bf16(bfr[n], af[m], acc[m][n], 0, 0, 0);  \
    }                                                                                              \
  }
  if (DEEP) {
    GLOAD(ra0, rb0, 0);
    if (nk > 1) GLOAD(ra1, rb1, 1);
    LWRITE(ra0, rb0, 0);
    __syncthreads();
    if (nk > 2) GLOAD(ra0, rb0, 2);
    for (int kt = 0; kt < nk; kt += 2) {
      COMPUTE(0);
      if (kt + 1 < nk) LWRITE(ra1, rb1, 1);
      __syncthreads();
      if (kt + 3 < nk) GLOAD(ra1, rb1, kt + 3);
      if (kt + 1 < nk) {
        COMPUTE(1);
        if (kt + 2 < nk) LWRITE(ra0, rb0, 0);
        __syncthreads();
        if (kt + 4 < nk) GLOAD(ra0, rb0, kt + 4);
      }
    }
  } else {
    GLOAD(ra0, rb0, 0);
    LWRITE(ra0, rb0, 0);
    __syncthreads();
    for (int kt = 0; kt < nk; kt += 2) {
      if (kt + 1 < nk) GLOAD(ra0, rb0, kt + 1);
      COMPUTE(0);
      if (kt + 1 < nk) LWRITE(ra0, rb0, 1);
      __syncthreads();
      if (kt + 1 < nk) {
        if (kt + 2 < nk) GLOAD(ra0, rb0, kt + 2);
        COMPUTE(1);
        if (kt + 2 < nk) LWRITE(ra0, rb0, 0);
        __syncthreads();
      }
    }
  }
#undef GLOAD
#undef LWRITE
#undef COMPUTE
}

template <class AL, class EP, bool DEEP = true, bool SPLIT = false>
DEV void gemm_tiles(char* smem, const u16* __restrict__ Bt, int ldb, int K, int nM, int nN, int tile_off,
                    const AL& al, const EP& ep, float* part = nullptr) {
  const int tid = threadIdx.x, lane = tid & 63, wave = tid >> 6;
  const int wm = wave >> 1, wn = wave & 1, fr = lane & 15, fq = lane >> 4;
  const int ntiles = nM * nN;
  const int nslots = gridDim.x >> 3, xcd = blockIdx.x & 7;
  const int per = (ntiles + 7) >> 3;
  int slot = (int)(blockIdx.x >> 3) - (tile_off % nslots);
  if (slot < 0) slot += nslots;
  const int nkfull = K >> 6;
  const int full = SPLIT ? (per / nslots) * nslots : per;
  for (int L = slot; L < full; L += nslots) {
    const int gidx = xcd * per + L;
    if (gidx >= ntiles) break;
    const int grp = gidx / (GM * nN), rem = gidx - grp * (GM * nN);
    const int gm = min(GM, nM - grp * GM);
    const int tn = rem / gm, tm = grp * GM + (rem - tn * gm);
    const int row0 = tm * 128, col0 = tn * 128;
    f32x4 acc[4][4];
    gemm_kloop<AL, DEEP>(smem, Bt, ldb, al, row0, col0, tn, 0, nkfull, acc);
    ep(acc, row0 + wm * 64, col0 + wn * 64, lane);
  }
  if (SPLIT) {
    const int ntail = per - full;
    if (ntail > 0) {
      const int S = nslots / ntail;
      if (slot < ntail * S) {
        const int ti = slot / S, ksl = slot - ti * S;
        const int gidx = xcd * per + full + ti;
        if (gidx < ntiles) {
          const int kt_lo = (ksl * nkfull) / S, nk = ((ksl + 1) * nkfull) / S - kt_lo;
          const int grp = gidx / (GM * nN), rem = gidx - grp * (GM * nN);
          const int gm = min(GM, nM - grp * GM);
          const int tn = rem / gm, tm = grp * GM + (rem - tn * gm);
          f32x4 acc[4][4];
          gemm_kloop<AL, false>(smem, Bt, ldb, al, tm * 128, tn * 128, tn, kt_lo, nk, acc);
          float* dst = part + ((size_t)((xcd * ntail + ti) * S + ksl) << 14);
#pragma unroll
          for (int m = 0; m < 4; ++m)
#pragma unroll
            for (int n = 0; n < 4; ++n)
              *(f32x4*)(dst + (wm * 64 + m * 16 + fr) * 128 + wn * 64 + fq * 16 + n * 4) = acc[m][n];
        }
      }
    }
  }
}

template <class AL, class EP>
DEV void gemm256(char* smem, const u16* __restrict__ Bt, int ldb, int K, int nM, int nN, const AL& al, const EP& ep) {
  const int tid = threadIdx.x, lane = tid & 63, wave = tid >> 6;
  const int wm = wave >> 1, wn = wave & 1, fr = lane & 15, fq = lane >> 4;
  const int ntiles = nM * nN;
  const int nslots = gridDim.x >> 3, xcd = blockIdx.x & 7;
  const int per = (ntiles + 7) >> 3;
  const int slot = blockIdx.x >> 3;
  const int nk = K >> 5;
  const int lr = tid >> 2, lc = tid & 3;
  const int kA = (0x1320 >> (((fr >> 2) & 3) * 4)) & 3;
  const int kBb = (0x1320 >> ((fr >> 2) * 4)) & 3;
  for (int L = slot; L < per; L += nslots) {
    const int gidx = xcd * per + L;
    if (gidx >= ntiles) break;
    const int grp = gidx / (2 * nN), rem = gidx - grp * (2 * nN);
    const int gm = min(2, nM - grp * 2);
    const int tn = rem / gm, tm = grp * 2 + (rem - tn * gm);
    const int row0 = tm * 256, col0 = tn * 128;
    f32x4 acc[2][4][4];
#pragma unroll
    for (int h = 0; h < 2; ++h)
#pragma unroll
      for (int m = 0; m < 4; ++m)
#pragma unroll
        for (int n = 0; n < 4; ++n) acc[h][m][n] = f32x4{0.f, 0.f, 0.f, 0.f};
    bf16x8 ra0[4], rb0[2], ra1[4], rb1[2];
#define GLOAD2(ra, rb, kt)                                                                         \
  {                                                                                                \
    const int kk_ = (kt) * 32 + lc * 8;                                                            \
    _Pragma("unroll") for (int i = 0; i < 4; ++i) ra[i] = al(row0 + lr + i * 64, kk_, tn);         \
    _Pragma("unroll") for (int i = 0; i < 2; ++i)                                                  \
      rb[i] = *(const bf16x8*)(Bt + (size_t)(col0 + lr + i * 64) * ldb + kk_);                     \
  }
#define LWRITE2(ra, rb, stage)                                                                     \
  {                                                                                                \
    _Pragma("unroll") for (int i = 0; i < 4; ++i) {                                                \
      const int r_ = lr + i * 64;                                                                  \
      const int ka_ = (0x1320 >> (((r_ >> 2) & 3) * 4)) & 3;                                       \
      *(bf16x8*)(smem + (stage) * 24576 + r_ * 64 + ((lc ^ ka_) << 4)) = ra[i];                    \
    }                                                                                              \
    _Pragma("unroll") for (int i = 0; i < 2; ++i) {                                                \
      const int r_ = lr + i * 64;                                                                  \
      *(bf16x8*)(smem + (stage) * 24576 + 16384 + r_ * 64 + ((lc ^ ((0x1320 >> (((r_ >> 4) & 3) * 4)) & 3)) << 4)) = rb[i]; \
    }                                                                                              \
  }
#define COMPUTE2(stage)                                                                            \
  {                                                                                                \
    const char* sa_ = smem + (stage) * 24576;                                                      \
    const char* sb_ = sa_ + 16384;                                                                 \
    bf16x8 bfr[4];                                                                                 \
    _Pragma("unroll") for (int n = 0; n < 4; ++n)                                                  \
      bfr[n] = *(const bf16x8*)(sb_ + (wn * 64 + (fr >> 2) * 16 + n * 4 + (fr & 3)) * 64 + ((fq ^ kBb) << 4)); \
    _Pragma("unroll") for (int h = 0; h < 2; ++h) {                                                \
      bf16x8 af[4];                                                                                \
      _Pragma("unroll") for (int m = 0; m < 4; ++m)                                                \
        af[m] = *(const bf16x8*)(sa_ + (wm * 128 + h * 64 + m * 16 + fr) * 64 + ((fq ^ kA) << 4)); \
      _Pragma("unroll") for (int m = 0; m < 4; ++m)                                                \
        _Pragma("unroll") for (int n = 0; n < 4; ++n)                                              \
          acc[h][m][n] = __builtin_amdgcn_mfma_f32_16x16x32_bf16(bfr[n], af[m], acc[h][m][n], 0, 0, 0); \
    }                                                                                              \
  }
    GLOAD2(ra0, rb0, 0);
    if (nk > 1) GLOAD2(ra1, rb1, 1);
    LWRITE2(ra0, rb0, 0);
    __syncthreads();
    if (nk > 2) GLOAD2(ra0, rb0, 2);
    for (int kt = 0; kt < nk; kt += 2) {
      COMPUTE2(0);
      if (kt + 1 < nk) LWRITE2(ra1, rb1, 1);
      __syncthreads();
      if (kt + 3 < nk) GLOAD2(ra1, rb1, kt + 3);
      if (kt + 1 < nk) {
        COMPUTE2(1);
        if (kt + 2 < nk) LWRITE2(ra0, rb0, 0);
        __syncthreads();
        if (kt + 4 < nk) GLOAD2(ra0, rb0, kt + 4);
      }
    }
    ep(acc[0], row0 + wm * 128, col0 + wn * 64, lane);
    ep(acc[1], row0 + wm * 128 + 64, col0 + wn * 64, lane);
  }
#undef GLOAD2
#undef LWRITE2
#undef COMPUTE2
}

DEV void transpose_job(char* smem, const float* __restrict__ src, int K, int Nsrc, u16* __restrict__ dst, int dst_rows,
                       int perm, int& tile_off) {
  float* tile = (float*)smem;
  const int tid = threadIdx.x;
  const int G = gridDim.x;
  const int nkt = K >> 6, nnt = dst_rows >> 6;
  const int ntiles = nkt * nnt;
  int start = (int)blockIdx.x - (tile_off % G);
  if (start < 0) start += G;
  for (int t = start; t < ntiles; t += G) {
    const int kt = t % nkt, nt = t / nkt;
    const int k0 = kt * 64, n0 = nt * 64;
#pragma unroll
    for (int i = 0; i < 4; ++i) {
      const int id = tid + i * 256;
      const int kk = id >> 4, n4 = (id & 15) * 4;
      float4 v = {0.f, 0.f, 0.f, 0.f};
      if (n0 + n4 < Nsrc) v = *(const float4*)(src + (size_t)(k0 + kk) * Nsrc + n0 + n4);
      tile[kk * 65 + n4 + 0] = v.x; tile[kk * 65 + n4 + 1] = v.y;
      tile[kk * 65 + n4 + 2] = v.z; tile[kk * 65 + n4 + 3] = v.w;
    }
    __syncthreads();
#pragma unroll
    for (int i = 0; i < 2; ++i) {
      const int id = tid + i * 256;
      const int nn = id >> 3, k8 = (id & 7) * 8;
      bf16x8 o;
#pragma unroll
      for (int e = 0; e < 8; ++e) o[e] = f2bf(tile[(k8 + e) * 65 + nn]);
      int n = n0 + nn, R = n;
      if (perm) {
        const int up = n >= FF, g = up ? n - FF : n;
        const int w = g & 31, e = w & 7;
        R = (g >> 5) * 64 + (w >> 3) * 16 + ((e >> 2) + (up ? 2 : 0)) * 4 + (e & 3);
      }
      *(bf16x8*)(dst + (size_t)R * K + k0 + k8) = o;
    }
    __syncthreads();
  }
  tile_off += ntiles;
}

DEV void phase_prep(const Params& p, int layer, char* smem) {
  char* W = p.ws + OFF_W;
  int off = 0;
  for (int h = 0; h < 2; ++h) {
    transpose_job(smem, p.in[I_WI] + (size_t)(layer * 2 + h) * D * (2 * FF), D, 2 * FF,
                  (u16*)(W + (h ? W_WI1 : W_WI0)), 2 * FF, 1, off);
    transpose_job(smem, p.in[I_WO] + (size_t)(layer * 2 + h) * FF * D, FF, D, (u16*)(W + (h ? W_WO1 : W_WO0)), D, 0, off);
  }
  if (layer == 0) {
    transpose_job(smem, p.in[I_EVIN], D, PLD, (u16*)(W + W_IN), 4224, 0, off);
    transpose_job(smem, p.in[I_EVOUT], D, D, (u16*)(W + W_OUT), D, 0, off);
    {
      float* LBT = (float*)(p.ws + OFF_LBT);
      for (int i = blockIdx.x * 256 + threadIdx.x; i < 1024; i += gridDim.x * 256) {
        const float* lg = p.in[I_LB];
        const float l0 = lg[i], l1 = lg[1024 + i], l2 = lg[2048 + i];
        const float mx = fmaxf(l0, fmaxf(l1, l2));
        const float e0 = __expf(l0 - mx), e1 = __expf(l1 - mx), e2 = __expf(l2 - mx);
        LBT[i] = e0 / (e0 + e1 + e2);
      }
    }
    float* sc = (float*)smem;
    float* red = (float*)(smem + 20480);
    const int tid = threadIdx.x;
    __syncthreads();
    for (int i = tid; i < 5 * D; i += 256) {
      const int s = i >> 10, k = i & 1023;
      const float v = s < 4 ? p.in[I_C][s * D + k] : p.in[I_CCTX][k];
      sc[i] = silu(v);
    }
    __syncthreads();
    const int G = gridDim.x;
    int start = (int)blockIdx.x - (off % G);
    if (start < 0) start += G;
    float* MOD = (float*)(p.ws + OFF_MOD);
    for (int u = start; u < 288; u += G) {
      const int l = u / 144, j0 = (u % 144) * 64;
      const int jj = tid & 63, kg = tid >> 6;
      const float* w = p.in[I_ADAW] + (size_t)l * D * 9216 + j0 + jj;
      float a0 = 0.f, a1 = 0.f, a2 = 0.f, a3 = 0.f, a4 = 0.f;
#pragma unroll 8
      for (int k = kg * 256; k < kg * 256 + 256; ++k) {
        const float wv = w[(size_t)k * 9216];
        a0 += sc[k] * wv; a1 += sc[1024 + k] * wv; a2 += sc[2048 + k] * wv; a3 += sc[3072 + k] * wv; a4 += sc[4096 + k] * wv;
      }
      float* rr = red + (kg * 64 + jj) * 5;
      rr[0] = a0; rr[1] = a1; rr[2] = a2; rr[3] = a3; rr[4] = a4;
      __syncthreads();
      for (int i = tid; i < 320; i += 256) {
        const int s = i / 64, j = i % 64;
        const float v = red[(0 * 64 + j) * 5 + s] + red[(1 * 64 + j) * 5 + s] + red[(2 * 64 + j) * 5 + s] + red[(3 * 64 + j) * 5 + s];
        MOD[(size_t)(l * 5 + s) * 9216 + j0 + j] = v + p.in[I_ADAB][l * 9216 + j0 + j];
      }
      __syncthreads();
    }
  } else {
    transpose_job(smem, p.in[I_WR], D, D, (u16*)(W + W_R), D, 0, off);
    transpose_job(smem, p.in[I_WK], D, D, (u16*)(W + W_K), D, 0, off);
    transpose_job(smem, p.in[I_WV], D, D, (u16*)(W + W_V), D, 0, off);
    transpose_job(smem, p.in[I_WOO], D, D, (u16*)(W + W_O), D, 0, off);
    for (int d = 0; d < 2; ++d) {
      transpose_job(smem, p.in[I_W1] + (size_t)d * D * 64, D, 64, (u16*)(W + W_W1) + (size_t)d * 64 * D, 64, 0, off);
      transpose_job(smem, p.in[I_A1] + (size_t)d * D * 64, D, 64, (u16*)(W + W_A1) + (size_t)d * 64 * D, 64, 0, off);
      transpose_job(smem, p.in[I_W2] + (size_t)d * 64 * D, 64, D, (u16*)(W + W_W2) + (size_t)d * D * 64, D, 0, off);
      transpose_job(smem, p.in[I_A2] + (size_t)d * 64 * D, 64, D, (u16*)(W + W_A2) + (size_t)d * D * 64, D, 0, off);
    }
    transpose_job(smem, p.in[I_G1], D, 128, (u16*)(W + W_G1), 128, 0, off);
    transpose_job(smem, p.in[I_G2], 128, D, (u16*)(W + W_G2), D, 0, off);
  }
}

DEV void phase_norm(const Params& p, const float* xlat, const float* xctx, const float* g, const float* modl,
                    int slot, int nrows, int fix_nM = 0, int fix_gidx = 0, float fix_scale = 0.f,
                    const float* fix_lat = nullptr, const float* fix_ctx = nullptr, const float* fix_modl = nullptr) {
  u16* H = (u16*)(p.ws + OFF_S + S_H);
  const int lane = threadIdx.x & 63;
  const int gw = blockIdx.x * 4 + (threadIdx.x >> 6), stride = gridDim.x * 4;
  for (int row = gw; row < nrows; row += stride) {
    const float4* src = (const float4*)xrow_ptr(xlat, xctx, row);
    const float* mm = modl + (size_t)mod_idx(row) * 9216 + slot * 3 * 1024;
    float4 v[4];
    float ss = 0.f;
#pragma unroll
    for (int i = 0; i < 4; ++i) {
      v[i] = src[lane + i * 64];
      if (fix_nM) {
        const int nN_ = 8, nslots_ = gridDim.x >> 3;
        const int per_ = (fix_nM * nN_ + 7) >> 3, full_ = (per_ / nslots_) * nslots_, ntail_ = per_ - full_;
        if (ntail_ > 0) {
          const int S_ = nslots_ / ntail_;
          const int c = (lane + i * 64) * 4, tn_ = c >> 7, tm_ = row >> 7;
          const int grp_ = tm_ / GM, gm_ = min(GM, fix_nM - grp_ * GM);
          const int gidx_ = grp_ * (GM * nN_) + tn_ * gm_ + (tm_ - grp_ * GM);
          const int xcd_ = gidx_ / per_, L_ = gidx_ - xcd_ * per_;
          if (L_ >= full_) {
            const float* part = (const float*)(p.ws + OFF_S + S_PART) + ((size_t)((xcd_ * ntail_ + (L_ - full_)) * S_) << 14) +
                                (row & 127) * 128 + (c & 127);
            float4 sum = {0.f, 0.f, 0.f, 0.f};
            for (int sl = 0; sl < S_; ++sl) {
              const float4 pv = *(const float4*)(part + ((size_t)sl << 14));
              sum.x += pv.x; sum.y += pv.y; sum.z += pv.z; sum.w += pv.w;
            }
            const float4 g4 = *(const float4*)(fix_modl + (size_t)mod_idx(row) * 9216 + fix_gidx * 1024 + c);
            const float4 xr = *(const float4*)(xrow_ptr(fix_lat, fix_ctx, row) + c);
            v[i].x = xr.x + fix_scale * g4.x * sum.x; v[i].y = xr.y + fix_scale * g4.y * sum.y;
            v[i].z = xr.z + fix_scale * g4.z * sum.z; v[i].w = xr.w + fix_scale * g4.w * sum.w;
            *(float4*)((float*)(p.ws + OFF_X) + (size_t)row * D + c) = v[i];
          }
        }
      }
      ss += v[i].x * v[i].x + v[i].y * v[i].y + v[i].z * v[i].z + v[i].w * v[i].w;
    }
    ss = red64(ss);
    const float rstd = rsqrtf(ss * (1.0f / 1024.0f) + 1e-6f);
#pragma unroll
    for (int i = 0; i < 4; ++i) {
      const int c = (lane + i * 64) * 4;
      const float4 gg = *(const float4*)(g + c);
      const float4 sh = *(const float4*)(mm + c);
      const float4 scl = *(const float4*)(mm + 1024 + c);
      bf16x4 o;
      o[0] = f2bf(v[i].x * rstd * gg.x * (1.0f + scl.x) + sh.x);
      o[1] = f2bf(v[i].y * rstd * gg.y * (1.0f + scl.y) + sh.y);
      o[2] = f2bf(v[i].z * rstd * gg.z * (1.0f + scl.z) + sh.z);
      o[3] = f2bf(v[i].w * rstd * gg.w * (1.0f + scl.w) + sh.w);
      *(bf16x4*)(H + (size_t)row * D + c) = o;
    }
  }
}

DEV void phase_final(const Params& p) {
  const float* X = (const float*)(p.ws + OFF_X);
  const float* g = p.in[I_FINALG];
  const int lane = threadIdx.x & 63;
  const int gw = blockIdx.x * 4 + (threadIdx.x >> 6), stride = gridDim.x * 4;
  for (int row = gw; row < MLAT; row += stride) {
    const float4* src = (const float4*)(X + (size_t)row * D);
    float4 v[4];
    float ss = 0.f;
#pragma unroll
    for (int i = 0; i < 4; ++i) {
      v[i] = src[lane + i * 64];
      ss += v[i].x * v[i].x + v[i].y * v[i].y + v[i].z * v[i].z + v[i].w * v[i].w;
    }
    ss = red64(ss);
    const float rstd = rsqrtf(ss * (1.0f / 1024.0f) + 1e-6f);
#pragma unroll
    for (int i = 0; i < 4; ++i) {
      const int c = (lane + i * 64) * 4;
      const float4 gg = *(const float4*)(g + c);
      float4 o;
      o.x = v[i].x * rstd * gg.x; o.y = v[i].y * rstd * gg.y; o.z = v[i].z * rstd * gg.z; o.w = v[i].w * rstd * gg.w;
      *(float4*)(p.out + (size_t)row * D + c) = o;
    }
  }
}

DEV int scan_row(int s, int b, int d) {
  if (s < 256) return MLAT + b * 256 + (d ? 255 - s : s);
  const int s2 = s - 256;
  return b * 4096 + (d ? 4095 - s2 : s2);
}

DEV bf16x8 ld8(const u16* P, int row, int col) { return *(const bf16x8*)(P + (size_t)row * PLD + col); }

DEV void even_scan_unit(const Params& p, int unit, char* smem) {
  const u16* P = (const u16*)(p.ws + OFF_S + S_P);
  float* dec = (float*)smem;
  float* kin = dec + 2048;
  float* qo = kin + 2048;
  float* vin = qo + 2048;
  float* cw = vin + 512;
  const int tid = threadIdx.x, lane = tid & 63;
  const bool ssd = unit >= 128;
  const int u = unit & 127;
  const int b = u >> 5;
  int d, colbase;
  int h = 0, vq = 0;
  int head = 0, ph = 0, grp = 0;
  if (!ssd) { h = (u >> 3) & 3; d = (u >> 2) & 1; vq = u & 3; colbase = h * 128 + vq * 32; }
  else { head = (u >> 2) & 7; d = (u >> 1) & 1; ph = u & 1; grp = head >> 2; colbase = 512 + head * 64 + ph * 32; }
  u16* O = (u16*)(p.ws + OFF_S + (d ? S_O1 : S_H));

  const int tok = tid >> 4, part = tid & 15;
  float lbv[8];
  float dtb = 0.f, aneg = 0.f;
  if (!ssd) {
    const float* lg = p.in[I_LB];
#pragma unroll
    for (int e = 0; e < 8; ++e) {
      const int c = d * 512 + h * 128 + part * 8 + e;
      const float l0 = lg[c], l1 = lg[1024 + c], l2 = lg[2048 + c];
      const float mx = fmaxf(l0, fmaxf(l1, l2));
      const float e0 = __expf(l0 - mx), e1 = __expf(l1 - mx), e2 = __expf(l2 - mx);
      lbv[e] = e0 / (e0 + e1 + e2);
    }
  } else {
    dtb = p.in[I_DTB][d * 8 + head];
    aneg = -__expf(p.in[I_ALOG][d * 8 + head]);
    for (int i = tid; i < 288; i += 256) {
      int c;
      if (i < 128) c = 512 + grp * 128 + i;
      else if (i < 256) c = 768 + grp * 128 + (i - 128);
      else c = head * 64 + ph * 32 + (i - 256);
      cw[i * 4 + 0] = p.in[I_CONVW][c];
      cw[i * 4 + 1] = p.in[I_CONVW][1024 + c];
      cw[i * 4 + 2] = p.in[I_CONVW][2048 + c];
      cw[i * 4 + 3] = p.in[I_CONVB][c];
    }
  }
  const int kp = lane & 15, vg = tid >> 4;
  float S[8][2];
#pragma unroll
  for (int a = 0; a < 8; ++a) { S[a][0] = 0.f; S[a][1] = 0.f; }

  const bf16x8 z8 = {0, 0, 0, 0, 0, 0, 0, 0};
  bf16x8 q0 = z8, q1 = z8, q2 = z8, q3 = z8, q4 = z8, q5 = z8, q6 = z8, q7 = z8, q8 = z8;
  short dtraw = 0, dtraw2 = 0;
  const int tok2 = (tid >> 2) & 15, part2 = tid & 3;
#define EV_ISSUE(c)                                                                              \
  {                                                                                              \
    const int row = scan_row((c) * 16 + tok, b, d);                                              \
    const int row2 = scan_row((c) * 16 + tok2, b, d);                                            \
    if (!ssd) {                                                                                  \
      q0 = ld8(P, row, 1024 + d * 512 + h * 128 + part * 8);                                     \
      q1 = ld8(P, row, h * 128 + part * 8);                                                      \
      q2 = ld8(P, row2, 512 + h * 128 + vq * 32 + part2 * 8);                                    \
    } else {                                                                                     \
      const bool lat = row < MLAT;                                                               \
      const int tpos = lat ? (row & 4095) : ((row - MLAT) & 255);                                \
      const int T = lat ? 4096 : 256;                                                            \
      const bool hm = tpos > 0, hp = tpos < T - 1;                                               \
      const int rm = hm ? row - 1 : row, rp = hp ? row + 1 : row;                                \
      const int cB = 3584 + grp * 128 + part * 8, cC = 3840 + grp * 128 + part * 8;              \
      q0 = ld8(P, rm, cB); q1 = ld8(P, row, cB); q2 = ld8(P, rp, cB);                            \
      q3 = ld8(P, rm, cC); q4 = ld8(P, row, cC); q5 = ld8(P, rp, cC);                            \
      if (!hm) { q0 = z8; q3 = z8; }                                                             \
      if (!hp) { q2 = z8; q5 = z8; }                                                             \
      dtraw = (short)P[(size_t)row * PLD + 4096 + d * 8 + head];                                 \
      const bool lat2 = row2 < MLAT;                                                             \
      const int tp2 = lat2 ? (row2 & 4095) : ((row2 - MLAT) & 255);                              \
      const int T2 = lat2 ? 4096 : 256;                                                          \
      const bool hm2 = tp2 > 0, hp2 = tp2 < T2 - 1;                                              \
      const int cX = 3072 + head * 64 + ph * 32 + part2 * 8;                                     \
      q6 = ld8(P, hm2 ? row2 - 1 : row2, cX); q7 = ld8(P, row2, cX); q8 = ld8(P, hp2 ? row2 + 1 : row2, cX); \
      if (!hm2) q6 = z8;                                                                         \
      if (!hp2) q8 = z8;                                                                         \
      dtraw2 = (short)P[(size_t)row2 * PLD + 4096 + d * 8 + head];                               \
    }                                                                                            \
  }
  __syncthreads();
  EV_ISSUE(0);
  const int NCH = (256 + 4096) / 16;
  for (int c = 0; c < NCH; ++c) {
    if (!ssd) {
      float fv[8], kv[8], qv[8];
#pragma unroll
      for (int e = 0; e < 8; ++e) {
        const float z = bf2f(q0[e]);
        const float sg = sigm(z);
        fv[e] = lbv[e] + (1.0f - lbv[e]) * sg;
        kv[e] = (1.0f - lbv[e]) * (1.0f - sg);
        qv[e] = silu(bf2f(q1[e]));
      }
      float* d0 = dec + tok * 128 + part * 8;
      float* k0 = kin + tok * 128 + part * 8;
      float* qq = qo + tok * 128 + part * 8;
      *(float4*)d0 = float4{fv[0], fv[1], fv[2], fv[3]}; *(float4*)(d0 + 4) = float4{fv[4], fv[5], fv[6], fv[7]};
      *(float4*)k0 = float4{kv[0], kv[1], kv[2], kv[3]}; *(float4*)(k0 + 4) = float4{kv[4], kv[5], kv[6], kv[7]};
      *(float4*)qq = float4{qv[0], qv[1], qv[2], qv[3]}; *(float4*)(qq + 4) = float4{qv[4], qv[5], qv[6], qv[7]};
      if (tid < 64) {
        float* vv = vin + (tid >> 2) * 32 + (tid & 3) * 8;
#pragma unroll
        for (int e = 0; e < 8; ++e) vv[e] = bf2f(q2[e]);
      }
    } else {
      const float dtv = bf2f(dtraw) + dtb;
      const float dt = dtv > 20.f ? dtv : __logf(1.0f + __expf(dtv));
      const float dc = __expf(dt * aneg);
      float bv[8], cv[8];
#pragma unroll
      for (int e = 0; e < 8; ++e) {
        const float4 wb = *(const float4*)(cw + (part * 8 + e) * 4);
        const float4 wc = *(const float4*)(cw + (128 + part * 8 + e) * 4);
        bv[e] = silu(wb.x * bf2f(q0[e]) + wb.y * bf2f(q1[e]) + wb.z * bf2f(q2[e]) + wb.w);
        cv[e] = silu(wc.x * bf2f(q3[e]) + wc.y * bf2f(q4[e]) + wc.z * bf2f(q5[e]) + wc.w);
      }
      float* d0 = dec + tok * 128 + part * 8;
      float* k0 = kin + tok * 128 + part * 8;
      float* qq = qo + tok * 128 + part * 8;
      *(float4*)d0 = float4{dc, dc, dc, dc}; *(float4*)(d0 + 4) = float4{dc, dc, dc, dc};
      *(float4*)k0 = float4{bv[0], bv[1], bv[2], bv[3]}; *(float4*)(k0 + 4) = float4{bv[4], bv[5], bv[6], bv[7]};
      *(float4*)qq = float4{cv[0], cv[1], cv[2], cv[3]}; *(float4*)(qq + 4) = float4{cv[4], cv[5], cv[6], cv[7]};
      if (tid < 64) {
        const float dtv2 = bf2f(dtraw2) + dtb;
        const float dt2 = dtv2 > 20.f ? dtv2 : __logf(1.0f + __expf(dtv2));
        float* vv = vin + (tid >> 2) * 32 + (tid & 3) * 8;
#pragma unroll
        for (int e = 0; e < 8; ++e) {
          const float4 wx = *(const float4*)(cw + (256 + (tid & 3) * 8 + e) * 4);
          vv[e] = dt2 * silu(wx.x * bf2f(q6[e]) + wx.y * bf2f(q7[e]) + wx.z * bf2f(q8[e]) + wx.w);
        }
      }
    }
    __syncthreads();
    if (c + 1 < NCH) EV_ISSUE(c + 1);
    float ok0 = 0.f, ok1 = 0.f;
#pragma unroll 4
    for (int t = 0; t < 16; ++t) {
      const float4 da = *(const float4*)(dec + t * 128 + kp * 8), db = *(const float4*)(dec + t * 128 + kp * 8 + 4);
      const float4 ka = *(const float4*)(kin + t * 128 + kp * 8), kb = *(const float4*)(kin + t * 128 + kp * 8 + 4);
      const float4 qa = *(const float4*)(qo + t * 128 + kp * 8), qb = *(const float4*)(qo + t * 128 + kp * 8 + 4);
      const float2 vv = *(const float2*)(vin + t * 32 + vg * 2);
      const float dd[8] = {da.x, da.y, da.z, da.w, db.x, db.y, db.z, db.w};
      const float kk[8] = {ka.x, ka.y, ka.z, ka.w, kb.x, kb.y, kb.z, kb.w};
      const float qq[8] = {qa.x, qa.y, qa.z, qa.w, qb.x, qb.y, qb.z, qb.w};
      float o0 = 0.f, o1 = 0.f;
#pragma unroll
      for (int a = 0; a < 8; ++a) {
        S[a][0] = dd[a] * S[a][0] + kk[a] * vv.x;
        S[a][1] = dd[a] * S[a][1] + kk[a] * vv.y;
        o0 += S[a][0] * qq[a];
        o1 += S[a][1] * qq[a];
      }
      o0 = red16(o0); o1 = red16(o1);
      ok0 = (kp == t) ? o0 : ok0;
      ok1 = (kp == t) ? o1 : ok1;
    }
    {
      const int row = scan_row(c * 16 + kp, b, d);
      bf16x2 ov; ov[0] = f2bf(ok0); ov[1] = f2bf(ok1);
      *(bf16x2*)(O + (size_t)row * D + colbase + vg * 2) = ov;
    }
    __syncthreads();
  }
}

#define MFMA16(a, b, c) __builtin_amdgcn_mfma_f32_16x16x32_bf16(a, b, c, 0, 0, 0)
DEV bf16x8 lds8(const u16* q) { return *(const bf16x8*)q; }

DEV void hgrn_chunk_unit(const Params& p, int u, char* smem) {
  const u16* P = (const u16*)(p.ws + OFF_S + S_P);
  u16* QH = (u16*)smem;
  u16* KH = QH + 4608;
  u16* QG = KH + 4608;
  u16* KTT = QG + 4608;
  u16* VT = KTT + 5120;
  u16* PB = VT + 1280;
  u16* ST = PB + 1280;
  float* TOT = (float*)(ST + 4608);
  float* DEC = TOT + 512;
  u16* RAWF = QG;
  u16* RAWQ = RAWF + 4096;
  const int tid = threadIdx.x, lane = tid & 63, wave = tid >> 6, fr = lane & 15, fq = lane >> 4;
  const int b = u >> 5, h = (u >> 3) & 3, d = (u >> 2) & 1, vq = u & 3;
  const int colbase = h * 128 + vq * 32;
  u16* O = (u16*)(p.ws + OFF_S + (d ? S_O1 : S_H));
  const int kp = tid & 63, g = tid >> 6, k0 = kp * 2;
  __syncthreads();
  for (int i = tid; i < 4608 / 2; i += 256) ((unsigned*)ST)[i] = 0u;
  f32x4 Sacc[2][2];
#pragma unroll
  for (int a = 0; a < 2; ++a)
#pragma unroll
    for (int c2 = 0; c2 < 2; ++c2) Sacc[a][c2] = f32x4{0.f, 0.f, 0.f, 0.f};
  bf16x8 pf0, pf1, pq0, pq1, pv;
  const int tokA = tid >> 4, k8 = (tid & 15) * 8;
  const int tokv = (tid >> 2) & 31, v8 = (tid & 3) * 8;
#define HG_ISSUE(c)                                                                         \
  {                                                                                         \
    const int r0_ = scan_row((c) * 32 + tokA, b, d), r1_ = scan_row((c) * 32 + tokA + 16, b, d); \
    pf0 = ld8(P, r0_, 1024 + d * 512 + h * 128 + k8); pf1 = ld8(P, r1_, 1024 + d * 512 + h * 128 + k8); \
    pq0 = ld8(P, r0_, h * 128 + k8); pq1 = ld8(P, r1_, h * 128 + k8);                       \
    pv = ld8(P, scan_row((c) * 32 + tokv, b, d), 512 + h * 128 + vq * 32 + v8);             \
  }
  HG_ISSUE(0);
  const int NCH = (256 + 4096) / 32;
  for (int c = 0; c < NCH; ++c) {
    *(bf16x8*)(RAWF + tokA * 128 + k8) = pf0; *(bf16x8*)(RAWF + (tokA + 16) * 128 + k8) = pf1;
    *(bf16x8*)(RAWQ + tokA * 128 + k8) = pq0; *(bf16x8*)(RAWQ + (tokA + 16) * 128 + k8) = pq1;
    if (tid < 128) {
#pragma unroll
      for (int e = 0; e < 8; ++e) VT[(v8 + e) * 40 + tokv] = (u16)pv[e];
    }
    __syncthreads();
    if (c + 1 < NCH) HG_ISSUE(c + 1);
    float qv[2][8], kv[2][8], cm[2][8];
    float cum0 = 1.f, cum1 = 1.f;
#pragma unroll
    for (int t = 0; t < 8; ++t) {
      const int tok = g * 8 + t;
      const bf16x2 rf = *(const bf16x2*)(RAWF + tok * 128 + k0);
      const bf16x2 rq2 = *(const bf16x2*)(RAWQ + tok * 128 + k0);
      kv[0][t] = bf2f(rf[0]); kv[1][t] = bf2f(rf[1]);
      qv[0][t] = bf2f(rq2[0]); qv[1][t] = bf2f(rq2[1]);
      cum0 *= 1.0f - kv[0][t]; cum1 *= 1.0f - kv[1][t];
      cm[0][t] = cum0; cm[1][t] = cum1;
    }
    *(float2*)(TOT + g * 128 + k0) = float2{cum0, cum1};
    __syncthreads();
    {
      const float2 ta = *(const float2*)(TOT + k0), tb = *(const float2*)(TOT + 128 + k0);
      const float2 tc = *(const float2*)(TOT + 256 + k0), td = *(const float2*)(TOT + 384 + k0);
      const float tt[2][4] = {{ta.x, tb.x, tc.x, td.x}, {ta.y, tb.y, tc.y, td.y}};
      bf16x8 ktv[2];
      float e0s[2], e1s[2];
#pragma unroll
      for (int cc = 0; cc < 2; ++cc) {
        const float pre = (g > 0 ? tt[cc][0] : 1.f) * (g > 1 ? tt[cc][1] : 1.f) * (g > 2 ? tt[cc][2] : 1.f);
        e0s[cc] = 1.0f;
        e1s[cc] = tt[cc][0] * tt[cc][1] * tt[cc][2] * tt[cc][3];
        const float off = pre;
#pragma unroll
        for (int t = 0; t < 8; ++t) {
          const float eq = cm[cc][t] * off, ek = __builtin_amdgcn_rcpf(eq);
          qv[cc][t] = qv[cc][t] * eq;
          kv[cc][t] = kv[cc][t] * ek;
          ktv[cc][t] = f2bf(kv[cc][t] * e1s[cc]);
        }
      }
#pragma unroll
      for (int t = 0; t < 8; ++t) {
        const int tok = g * 8 + t;
        bf16x2 o;
        o[0] = f2bf(kv[0][t]); o[1] = f2bf(kv[1][t]);
        *(bf16x2*)(KH + tok * 144 + k0) = o;
        o[0] = f2bf(qv[0][t]); o[1] = f2bf(qv[1][t]);
        *(bf16x2*)(QG + tok * 144 + k0) = o;
      }
      *(bf16x8*)(KTT + k0 * 40 + g * 8) = ktv[0];
      *(bf16x8*)(KTT + (k0 + 1) * 40 + g * 8) = ktv[1];
      if (g == 0) *(float2*)(DEC + k0) = float2{e0s[0] * e1s[0], e0s[1] * e1s[1]};
    }
    __syncthreads();
    if (wave < 3) {
      const int lt = wave ? 1 : 0, st = wave == 2 ? 1 : 0;
      f32x4 acc = {0.f, 0.f, 0.f, 0.f};
#pragma unroll
      for (int ks = 0; ks < 4; ++ks)
        acc = MFMA16(lds8(QG + (lt * 16 + fr) * 144 + ks * 32 + fq * 8), lds8(KH + (st * 16 + fr) * 144 + ks * 32 + fq * 8), acc);
#pragma unroll
      for (int j = 0; j < 4; ++j) {
        const int l = lt * 16 + fq * 4 + j, s2 = st * 16 + fr;
        PB[l * 40 + s2] = (u16)f2bf(s2 <= l ? acc[j] : 0.f);
      }
    } else {
#pragma unroll
      for (int j = 0; j < 4; ++j) PB[(fq * 4 + j) * 40 + 16 + fr] = 0;
    }
    __syncthreads();
    {
      const int lt = wave >> 1, vt = wave & 1;
      f32x4 acc = {0.f, 0.f, 0.f, 0.f};
#pragma unroll
      for (int ks = 0; ks < 4; ++ks)
        acc = MFMA16(lds8(QG + (lt * 16 + fr) * 144 + ks * 32 + fq * 8), lds8(ST + (vt * 16 + fr) * 144 + ks * 32 + fq * 8), acc);
      acc = MFMA16(lds8(PB + (lt * 16 + fr) * 40 + fq * 8), lds8(VT + (vt * 16 + fr) * 40 + fq * 8), acc);
#pragma unroll
      for (int j = 0; j < 4; ++j) {
        const int row = scan_row(c * 32 + lt * 16 + fq * 4 + j, b, d);
        O[(size_t)row * D + colbase + vt * 16 + fr] = (u16)f2bf(acc[j]);
      }
#pragma unroll
      for (int a = 0; a < 2; ++a) {
        const int kt = wave * 2 + a;
        const float4 dc = *(const float4*)(DEC + kt * 16 + fq * 4);
        const bf16x8 af = lds8(KTT + (kt * 16 + fr) * 40 + fq * 8);
#pragma unroll
        for (int v2 = 0; v2 < 2; ++v2) {
          Sacc[a][v2][0] *= dc.x; Sacc[a][v2][1] *= dc.y; Sacc[a][v2][2] *= dc.z; Sacc[a][v2][3] *= dc.w;
          Sacc[a][v2] = MFMA16(af, lds8(VT + (v2 * 16 + fr) * 40 + fq * 8), Sacc[a][v2]);
        }
      }
    }
    __syncthreads();
#pragma unroll
    for (int a = 0; a < 2; ++a)
#pragma unroll
      for (int v2 = 0; v2 < 2; ++v2) {
        bf16x4 o;
#pragma unroll
        for (int j = 0; j < 4; ++j) o[j] = f2bf(Sacc[a][v2][j]);
        *(bf16x4*)(ST + (v2 * 16 + fr) * 144 + (wave * 2 + a) * 16 + fq * 4) = o;
      }
  }
  __syncthreads();
#undef HG_ISSUE
}

DEV void ssd_chunk_unit(const Params& p, int u, char* smem) {
  const u16* P = (const u16*)(p.ws + OFF_S + S_P);
  const u16* F = (const u16*)(p.ws + OFF_S + S_F);
  u16* CM = (u16*)smem;
  u16* BM = CM + 4608;
  u16* V1 = BM + 4608;
  u16* V2 = V1 + 1280;
  u16* PB = V2 + 1280;
  u16* ST = PB + 1280;
  float* LG = (float*)(ST + 4608);
  float* BC = LG + 32;
  const int tid = threadIdx.x, lane = tid & 63, wave = tid >> 6, fr = lane & 15, fq = lane >> 4;
  const int b = u >> 5, head = (u >> 2) & 7, d = (u >> 1) & 1, ph = u & 1, grp = head >> 2;
  const int colbase = 512 + head * 64 + ph * 32;
  u16* O = (u16*)(p.ws + OFF_S + (d ? S_O1 : S_H));
  const float dtb = p.in[I_DTB][d * 8 + head];
  const float aneg = -__expf(p.in[I_ALOG][d * 8 + head]);
  __syncthreads();
  for (int i = tid; i < 4608 / 2; i += 256) ((unsigned*)ST)[i] = 0u;
  f32x4 Sacc[2][2];
#pragma unroll
  for (int a = 0; a < 2; ++a)
#pragma unroll
    for (int c2 = 0; c2 < 2; ++c2) Sacc[a][c2] = f32x4{0.f, 0.f, 0.f, 0.f};
  const int tok = tid >> 3, part = tid & 7, n16 = part * 16;
  bf16x8 b0, b1, c0, c1;
  bf16x4 x0;
  short dtraw;
#define SD_ISSUE(c)                                                                         \
  {                                                                                         \
    const int row = scan_row((c) * 32 + tok, b, d);                                         \
    const u16* fr_ = F + (size_t)row * D;                                                   \
    b0 = *(const bf16x8*)(fr_ + 512 + grp * 128 + n16); b1 = *(const bf16x8*)(fr_ + 512 + grp * 128 + n16 + 8); \
    c0 = *(const bf16x8*)(fr_ + 768 + grp * 128 + n16); c1 = *(const bf16x8*)(fr_ + 768 + grp * 128 + n16 + 8); \
    x0 = *(const bf16x4*)(fr_ + head * 64 + ph * 32 + part * 4);                            \
    dtraw = (short)P[(size_t)row * PLD + 4096 + d * 8 + head];                              \
  }
  SD_ISSUE(0);
  __syncthreads();
  const int NCH = (256 + 4096) / 32;
  for (int c = 0; c < NCH; ++c) {
    const float dtv = bf2f(dtraw) + dtb;
    const float dt = dtv > 20.f ? dtv : __logf(1.0f + __expf(dtv));
    float dtx[4];
    *(bf16x8*)(BM + tok * 144 + n16) = b0; *(bf16x8*)(BM + tok * 144 + n16 + 8) = b1;
    *(bf16x8*)(CM + tok * 144 + n16) = c0; *(bf16x8*)(CM + tok * 144 + n16 + 8) = c1;
    {
#pragma unroll
      for (int e = 0; e < 4; ++e) { dtx[e] = dt * bf2f(x0[e]); V1[(part * 4 + e) * 40 + tok] = (u16)f2bf(dtx[e]); }
    }
    if (part == 0) LG[tok] = dt * aneg;
    __syncthreads();
    if (c + 1 < NCH) SD_ISSUE(c + 1);
    float bt = 0.f, tot = 0.f;
#pragma unroll
    for (int i4 = 0; i4 < 8; ++i4) {
      const float4 v4 = *(const float4*)(LG + i4 * 4);
      const float vv[4] = {v4.x, v4.y, v4.z, v4.w};
#pragma unroll
      for (int e = 0; e < 4; ++e) {
        tot += vv[e];
        bt += (i4 * 4 + e <= tok) ? vv[e] : 0.f;
      }
    }
    if (part == 0) BC[tok] = bt;
    {
      const float e2 = __expf(tot - bt);
#pragma unroll
      for (int e = 0; e < 4; ++e) V2[(part * 4 + e) * 40 + tok] = (u16)f2bf(e2 * dtx[e]);
    }
    const float decS = __expf(tot);
    __syncthreads();
    if (wave < 3) {
      const int lt = wave ? 1 : 0, st = wave == 2 ? 1 : 0;
      f32x4 acc = {0.f, 0.f, 0.f, 0.f};
#pragma unroll
      for (int ks = 0; ks < 4; ++ks)
        acc = MFMA16(lds8(CM + (lt * 16 + fr) * 144 + ks * 32 + fq * 8), lds8(BM + (st * 16 + fr) * 144 + ks * 32 + fq * 8), acc);
      const float4 bl = *(const float4*)(BC + lt * 16 + fq * 4);
      const float bs = BC[st * 16 + fr];
      const float blv[4] = {bl.x, bl.y, bl.z, bl.w};
#pragma unroll
      for (int j = 0; j < 4; ++j) {
        const int l = lt * 16 + fq * 4 + j, s2 = st * 16 + fr;
        PB[l * 40 + s2] = (u16)f2bf(s2 <= l ? acc[j] * __expf(blv[j] - bs) : 0.f);
      }
    } else {
#pragma unroll
      for (int j = 0; j < 4; ++j) PB[(fq * 4 + j) * 40 + 16 + fr] = 0;
    }
    __syncthreads();
    {
      const int lt = wave >> 1, vt = wave & 1;
      f32x4 acc = {0.f, 0.f, 0.f, 0.f};
#pragma unroll
      for (int ks = 0; ks < 4; ++ks)
        acc = MFMA16(lds8(CM + (lt * 16 + fr) * 144 + ks * 32 + fq * 8), lds8(ST + (vt * 16 + fr) * 144 + ks * 32 + fq * 8), acc);
      const float4 bl = *(const float4*)(BC + lt * 16 + fq * 4);
      acc[0] *= __expf(bl.x); acc[1] *= __expf(bl.y); acc[2] *= __expf(bl.z); acc[3] *= __expf(bl.w);
      bf16x8 v2f[2], bt8[2];
      const bf16x8 v1f = lds8(V1 + (vt * 16 + fr) * 40 + fq * 8);
      v2f[0] = lds8(V2 + fr * 40 + fq * 8);
      v2f[1] = lds8(V2 + (16 + fr) * 40 + fq * 8);
#pragma unroll
      for (int e = 0; e < 8; ++e) {
        bt8[0][e] = (short)BM[(fq * 8 + e) * 144 + (wave * 2) * 16 + fr];
        bt8[1][e] = (short)BM[(fq * 8 + e) * 144 + (wave * 2 + 1) * 16 + fr];
      }
      acc = MFMA16(lds8(PB + (lt * 16 + fr) * 40 + fq * 8), v1f, acc);
#pragma unroll
      for (int j = 0; j < 4; ++j) {
        const int row = scan_row(c * 32 + lt * 16 + fq * 4 + j, b, d);
        O[(size_t)row * D + colbase + vt * 16 + fr] = (u16)f2bf(acc[j]);
      }
#pragma unroll
      for (int a = 0; a < 2; ++a)
#pragma unroll
        for (int v2 = 0; v2 < 2; ++v2) {
          Sacc[a][v2][0] *= decS; Sacc[a][v2][1] *= decS; Sacc[a][v2][2] *= decS; Sacc[a][v2][3] *= decS;
          Sacc[a][v2] = MFMA16(bt8[a], v2f[v2], Sacc[a][v2]);
        }
    }
    __syncthreads();
#pragma unroll
    for (int a = 0; a < 2; ++a)
#pragma unroll
      for (int v2 = 0; v2 < 2; ++v2) {
        bf16x4 o;
#pragma unroll
        for (int j = 0; j < 4; ++j) o[j] = f2bf(Sacc[a][v2][j]);
        *(bf16x4*)(ST + (v2 * 16 + fr) * 144 + (wave * 2 + a) * 16 + fq * 4) = o;
      }
  }
  __syncthreads();
#undef SD_ISSUE
}

DEV void phase_xbc_conv(const Params& p, int nrows) {
  const u16* P = (const u16*)(p.ws + OFF_S + S_P);
  u16* F = (u16*)(p.ws + OFF_S + S_F);
  const int lane = threadIdx.x & 63;
  const int gw = blockIdx.x * 4 + (threadIdx.x >> 6), stride = gridDim.x * 4;
  const float* cw = p.in[I_CONVW];
  const float* cb = p.in[I_CONVB];
  for (int row = gw; row < nrows; row += stride) {
    const bool lat = row < MLAT;
    const int tpos = lat ? (row & 4095) : ((row - MLAT) & 255);
    const int T = lat ? 4096 : 256;
    const bool hm = tpos > 0, hp = tpos < T - 1;
    const float fm = hm ? 1.f : 0.f, fp = hp ? 1.f : 0.f;
    const int rm = hm ? row - 1 : row, rp = hp ? row + 1 : row;
#pragma unroll
    for (int hh = 0; hh < 2; ++hh) {
      const int c = lane * 16 + hh * 8;
      const bf16x8 xm = ld8(P, rm, 3072 + c), x0 = ld8(P, row, 3072 + c), xp = ld8(P, rp, 3072 + c);
      float w0[8], w1[8], w2[8], bb[8];
      *(float4*)(w0) = *(const float4*)(cw + c); *(float4*)(w0 + 4) = *(const float4*)(cw + c + 4);
      *(float4*)(w1) = *(const float4*)(cw + 1024 + c); *(float4*)(w1 + 4) = *(const float4*)(cw + 1024 + c + 4);
      *(float4*)(w2) = *(const float4*)(cw + 2048 + c); *(float4*)(w2 + 4) = *(const float4*)(cw + 2048 + c + 4);
      *(float4*)(bb) = *(const float4*)(cb + c); *(float4*)(bb + 4) = *(const float4*)(cb + c + 4);
      bf16x8 o;
#pragma unroll
      for (int e = 0; e < 8; ++e)
        o[e] = f2bf(silu(w0[e] * fm * bf2f(xm[e]) + w1[e] * bf2f(x0[e]) + w2[e] * fp * bf2f(xp[e]) + bb[e]));
      *(bf16x8*)(F + (size_t)row * D + c) = o;
    }
  }
}

DEV void phase_even_finish(const Params& p, int nrows) {
  const u16* P = (const u16*)(p.ws + OFF_S + S_P);
  u16* O0 = (u16*)(p.ws + OFF_S + S_H);
  const u16* O1 = (const u16*)(p.ws + OFF_S + S_O1);
  const int lane = threadIdx.x & 63;
  const int gw = blockIdx.x * 4 + (threadIdx.x >> 6), stride = gridDim.x * 4;
  const int c = lane * 8;
  for (int row = gw; row < nrows; row += stride) {
    {
      const bf16x8 a = *(const bf16x8*)(O0 + (size_t)row * D + c);
      const bf16x8 bq = *(const bf16x8*)(O1 + (size_t)row * D + c);
      const bf16x8 g = ld8(P, row, 2048 + c);
      float o[8], ss = 0.f;
#pragma unroll
      for (int e = 0; e < 8; ++e) { o[e] = bf2f(a[e]) + bf2f(bq[e]); ss += o[e] * o[e]; }
      ss = red16(ss);
      const float rstd = rsqrtf(ss * (1.0f / 128.0f) + 1e-6f);
      float hg[8];
      *(float4*)(hg) = *(const float4*)(p.in[I_HGRNG] + (c & 127)); *(float4*)(hg + 4) = *(const float4*)(p.in[I_HGRNG] + (c & 127) + 4);
      bf16x8 out;
#pragma unroll
      for (int e = 0; e < 8; ++e)
        out[e] = f2bf(o[e] * rstd * hg[e] * silu(bf2f(g[e])));
      *(bf16x8*)(O0 + (size_t)row * D + c) = out;
    }
    {
      const bf16x8 a = *(const bf16x8*)(O0 + (size_t)row * D + 512 + c);
      const bf16x8 bq = *(const bf16x8*)(O1 + (size_t)row * D + 512 + c);
      const bf16x8 z = ld8(P, row, 2560 + c);
      const bf16x8 xc = *(const bf16x8*)((const u16*)(p.ws + OFF_S + S_F) + (size_t)row * D + c);
      const float dsk = p.in[I_SSDD][c >> 6];
      float o[8], ss = 0.f;
#pragma unroll
      for (int e = 0; e < 8; ++e) {
        const float xs = bf2f(xc[e]);
        o[e] = (bf2f(a[e]) + bf2f(bq[e]) + dsk * xs) * silu(bf2f(z[e]));
        ss += o[e] * o[e];
      }
      ss = red16(ss);
      ss += __shfl_xor(ss, 16);
      const float rstd = rsqrtf(ss * (1.0f / 256.0f) + 1e-6f);
      float sg[8];
      *(float4*)(sg) = *(const float4*)(p.in[I_SSDG] + c); *(float4*)(sg + 4) = *(const float4*)(p.in[I_SSDG] + c + 4);
      bf16x8 out;
#pragma unroll
      for (int e = 0; e < 8; ++e) out[e] = f2bf(o[e] * rstd * sg[e]);
      *(bf16x8*)(O0 + (size_t)row * D + 512 + c) = out;
    }
  }
}

DEV void odd_scan_unit(const Params& p, int unit, char* smem) {
  float* wl = (float*)smem;
  float* kl = wl + 1024;
  float* al = kl + 1024;
  float* bl = al + 1024;
  float* rl = bl + 1024;
  float* at = rl + 1024;
  float* vl = at + 1024;
  const int tid = threadIdx.x, lane = tid & 63, wave = tid >> 6;
  const int fr = lane & 15, fq = lane >> 4;
  const int b = unit >> 6, head = (unit >> 2) & 15, d = (unit >> 1) & 1, rh = unit & 1;
  const char* S = p.ws + OFF_S;
  const u16* R = (const u16*)(S + S_R);
  const u16* Kb = (const u16*)(S + S_K);
  const u16* V = (const u16*)(S + S_V);
  const u16* LORA = (const u16*)(S + S_LORA);
  float* BON = (float*)(S + S_BON) + (size_t)d * MTOT * 16;
  u16* Y = (u16*)(S + (d ? S_Y1 : S_H));
  const u16* W2T = (const u16*)(p.ws + OFF_W + W_W2) + (size_t)d * D * 64;
  const u16* A2T = (const u16*)(p.ws + OFF_W + W_A2) + (size_t)d * D * 64;
  const int ncol = head * 64 + wave * 16 + fr;
  bf16x8 bw[2], ba[2];
#pragma unroll
  for (int ks = 0; ks < 2; ++ks) {
    bw[ks] = *(const bf16x8*)(W2T + (size_t)ncol * 64 + ks * 32 + fq * 8);
    ba[ks] = *(const bf16x8*)(A2T + (size_t)ncol * 64 + ks * 32 + fq * 8);
  }
  const float w0c = p.in[I_W0][d * D + ncol], a0c = p.in[I_A0][d * D + ncol];
  const int tok = tid >> 4, c4 = (tid & 15) * 4;
  float kkc[4], kac[4], rkc[4];
#pragma unroll
  for (int e = 0; e < 4; ++e) {
    kkc[e] = p.in[I_KK][head * 64 + c4 + e];
    kac[e] = p.in[I_KA][head * 64 + c4 + e];
    rkc[e] = p.in[I_RK][head * 64 + c4 + e];
  }
  const int jp = lane & 7, il = tid >> 3;
  float St[8];
#pragma unroll
  for (int j = 0; j < 8; ++j) St[j] = 0.f;

  bf16x8 fa0, fa1, fb0, fb1;
  bf16x4 kr, rr;
  bf16x2 vr;
#define OD_ISSUE(c)                                                                              \
  {                                                                                              \
    const int rowA = scan_row((c) * 16 + fr, b, d);                                              \
    fa0 = *(const bf16x8*)(LORA + (size_t)rowA * LLD + d * 64 + fq * 8);                         \
    fa1 = *(const bf16x8*)(LORA + (size_t)rowA * LLD + d * 64 + 32 + fq * 8);                    \
    fb0 = *(const bf16x8*)(LORA + (size_t)rowA * LLD + 128 + d * 64 + fq * 8);                   \
    fb1 = *(const bf16x8*)(LORA + (size_t)rowA * LLD + 128 + d * 64 + 32 + fq * 8);              \
    const int rowE = scan_row((c) * 16 + tok, b, d);                                             \
    kr = *(const bf16x4*)(Kb + (size_t)rowE * D + head * 64 + c4);                               \
    rr = *(const bf16x4*)(R + (size_t)rowE * D + head * 64 + c4);                                \
    vr = *(const bf16x2*)(V + (size_t)rowE * D + head * 64 + rh * 32 + (tid & 15) * 2);          \
  }
  OD_ISSUE(0);
  const int NCH = (256 + 4096) / 16;
  for (int c = 0; c < NCH; ++c) {
    f32x4 accw = {0.f, 0.f, 0.f, 0.f}, acca = {0.f, 0.f, 0.f, 0.f};
    accw = __builtin_amdgcn_mfma_f32_16x16x32_bf16(fa0, bw[0], accw, 0, 0, 0);
    accw = __builtin_amdgcn_mfma_f32_16x16x32_bf16(fa1, bw[1], accw, 0, 0, 0);
    acca = __builtin_amdgcn_mfma_f32_16x16x32_bf16(fb0, ba[0], acca, 0, 0, 0);
    acca = __builtin_amdgcn_mfma_f32_16x16x32_bf16(fb1, ba[1], acca, 0, 0, 0);
#pragma unroll
    for (int j = 0; j < 4; ++j) {
      const int t = fq * 4 + j, cc = wave * 16 + fr;
      const float zw = w0c + accw[j];
      wl[t * 64 + cc] = __expf(-0.6065306597126334f * sigm(zw));
      at[t * 64 + cc] = sigm(a0c + acca[j]);
    }
    __syncthreads();
    {
      const float4 a4 = *(const float4*)(at + tok * 64 + c4);
      const float av[4] = {a4.x, a4.y, a4.z, a4.w};
      float kku[4], kd[4], rv[4], ss = 0.f, bsum = 0.f;
#pragma unroll
      for (int e = 0; e < 4; ++e) {
        const float k = bf2f(kr[e]);
        rv[e] = bf2f(rr[e]);
        kku[e] = k * kkc[e];
        ss += kku[e] * kku[e];
        kd[e] = k * (1.0f + (av[e] - 1.0f) * kac[e]);
        bsum += rv[e] * kd[e] * rkc[e];
      }
      ss = red16(ss);
      bsum = red16(bsum);
      const float inv = rsqrtf(fmaxf(ss, 1e-24f));
      const int row = scan_row(c * 16 + tok, b, d);
      if ((tid & 15) == 0 && rh == 0) BON[(size_t)row * 16 + head] = bsum;
      float4 ko, ao, bo, ro;
      ko.x = kd[0]; ko.y = kd[1]; ko.z = kd[2]; ko.w = kd[3];
      ao.x = -kku[0] * inv; ao.y = -kku[1] * inv; ao.z = -kku[2] * inv; ao.w = -kku[3] * inv;
      bo.x = -ao.x * av[0]; bo.y = -ao.y * av[1]; bo.z = -ao.z * av[2]; bo.w = -ao.w * av[3];
      ro.x = rv[0]; ro.y = rv[1]; ro.z = rv[2]; ro.w = rv[3];
      *(float4*)(kl + tok * 64 + c4) = ko;
      *(float4*)(al + tok * 64 + c4) = ao;
      *(float4*)(bl + tok * 64 + c4) = bo;
      *(float4*)(rl + tok * 64 + c4) = ro;
      float2 vo; vo.x = bf2f(vr[0]); vo.y = bf2f(vr[1]);
      *(float2*)(vl + tok * 32 + (tid & 15) * 2) = vo;
    }
    __syncthreads();
    if (c + 1 < NCH) OD_ISSUE(c + 1);
    float yk0 = 0.f, yk1 = 0.f;
#pragma unroll 2
    for (int t = 0; t < 16; ++t) {
      const float4 w_a = *(const float4*)(wl + t * 64 + jp * 8), w_b = *(const float4*)(wl + t * 64 + jp * 8 + 4);
      const float4 k_a = *(const float4*)(kl + t * 64 + jp * 8), k_b = *(const float4*)(kl + t * 64 + jp * 8 + 4);
      const float4 a_a = *(const float4*)(al + t * 64 + jp * 8), a_b = *(const float4*)(al + t * 64 + jp * 8 + 4);
      const float4 b_a = *(const float4*)(bl + t * 64 + jp * 8), b_b = *(const float4*)(bl + t * 64 + jp * 8 + 4);
      const float4 r_a = *(const float4*)(rl + t * 64 + jp * 8), r_b = *(const float4*)(rl + t * 64 + jp * 8 + 4);
      const float vi = vl[t * 32 + il];
      const float ww[8] = {w_a.x, w_a.y, w_a.z, w_a.w, w_b.x, w_b.y, w_b.z, w_b.w};
      const float kk[8] = {k_a.x, k_a.y, k_a.z, k_a.w, k_b.x, k_b.y, k_b.z, k_b.w};
      const float aa[8] = {a_a.x, a_a.y, a_a.z, a_a.w, a_b.x, a_b.y, a_b.z, a_b.w};
      const float bb[8] = {b_a.x, b_a.y, b_a.z, b_a.w, b_b.x, b_b.y, b_b.z, b_b.w};
      const float rq[8] = {r_a.x, r_a.y, r_a.z, r_a.w, r_b.x, r_b.y, r_b.z, r_b.w};
      float sa = 0.f;
#pragma unroll
      for (int j = 0; j < 8; ++j) sa += St[j] * aa[j];
      sa = red8(sa);
      float y = 0.f;
#pragma unroll
      for (int j = 0; j < 8; ++j) {
        St[j] = St[j] * ww[j] + sa * bb[j] + vi * kk[j];
        y += St[j] * rq[j];
      }
      y = red8(y);
      yk0 = (jp == t) ? y : yk0;
      yk1 = (jp + 8 == t) ? y : yk1;
    }
    {
      const int row0 = scan_row(c * 16 + jp, b, d), row1 = scan_row(c * 16 + 8 + jp, b, d);
      Y[(size_t)row0 * D + head * 64 + rh * 32 + il] = (u16)f2bf(yk0);
      Y[(size_t)row1 * D + head * 64 + rh * 32 + il] = (u16)f2bf(yk1);
    }
    __syncthreads();
  }
}

DEV void phase_odd_finish(const Params& p, int nrows) {
  const char* S = p.ws + OFF_S;
  u16* Y0 = (u16*)(p.ws + OFF_S + S_H);
  const u16* Y1 = (const u16*)(S + S_Y1);
  const u16* V = (const u16*)(S + S_V);
  const u16* Gb = (const u16*)(S + S_G);
  const float* BON = (const float*)(S + S_BON);
  const int lane = threadIdx.x & 63;
  const int gw = blockIdx.x * 4 + (threadIdx.x >> 6), stride = gridDim.x * 4;
  const int c = lane * 16, head = lane >> 2;
  for (int row = gw; row < nrows; row += stride) {
    float y[16], sum = 0.f;
#pragma unroll
    for (int hh = 0; hh < 2; ++hh) {
      const bf16x8 a = *(const bf16x8*)(Y0 + (size_t)row * D + c + hh * 8);
      const bf16x8 bq = *(const bf16x8*)(Y1 + (size_t)row * D + c + hh * 8);
#pragma unroll
      for (int e = 0; e < 8; ++e) { y[hh * 8 + e] = bf2f(a[e]) + bf2f(bq[e]); sum += y[hh * 8 + e]; }
    }
    sum = red4(sum);
    const float mu = sum * (1.0f / 64.0f);
    float var = 0.f;
#pragma unroll
    for (int e = 0; e < 16; ++e) { const float dlt = y[e] - mu; var += dlt * dlt; }
    var = red4(var) * (1.0f / 64.0f);
    const float rstd = rsqrtf(var + 64e-5f);
    const float bon = BON[(size_t)row * 16 + head] + BON[(size_t)MTOT * 16 + (size_t)row * 16 + head];
#pragma unroll
    for (int hh = 0; hh < 2; ++hh) {
      const bf16x8 v = *(const bf16x8*)(V + (size_t)row * D + c + hh * 8);
      const bf16x8 g = *(const bf16x8*)(Gb + (size_t)row * D + c + hh * 8);
      float lw[8], lbv[8];
      *(float4*)(lw) = *(const float4*)(p.in[I_LNW] + c + hh * 8); *(float4*)(lw + 4) = *(const float4*)(p.in[I_LNW] + c + hh * 8 + 4);
      *(float4*)(lbv) = *(const float4*)(p.in[I_LNB] + c + hh * 8); *(float4*)(lbv + 4) = *(const float4*)(p.in[I_LNB] + c + hh * 8 + 4);
      bf16x8 out;
#pragma unroll
      for (int e = 0; e < 8; ++e) {
        const float yn = (y[hh * 8 + e] - mu) * rstd * lw[e] + lbv[e];
        out[e] = f2bf((yn + bon * bf2f(v[e])) * bf2f(g[e]));
      }
      *(bf16x8*)(Y0 + (size_t)row * D + c + hh * 8) = out;
    }
  }
}

constexpr int NPHASE = 30;

DEV void run_phase(const Params& p, int ph, char* smem) {
  char* S = p.ws + OFF_S;
  char* W = p.ws + OFF_W;
  float* X = (float*)(p.ws + OFF_X);
  const float* MOD = (const float*)(p.ws + OFF_MOD);
  u16* H = (u16*)(S + S_H);
  if (ph == 0) { phase_prep(p, 0, smem); return; }
  if (ph == 13) { phase_prep(p, 1, smem); return; }
  if (ph == 29) { phase_final(p); return; }
  const int layer = ph >= 14 ? 1 : 0;
  int q = layer ? ph - 14 : ph - 1;
  if (layer == 0 && q == 5) { phase_xbc_conv(p, MTOT); return; }
  if (layer == 0 && q > 5) q -= 1;
  if (layer == 1 && q >= 4 && q <= 7) {
    u16* XA0 = (u16*)(S + S_Y1);
    u16* XA1 = (u16*)(S + S_G);
    if (q == 4) { phase_mix(p, 0, XA0, 2, XA1, MTOT); return; }
    if (q == 5) {
      gemm_tiles(smem, (const u16*)(W + W_R), D, D, MTOT / 128, 16, 0, ATwo{XA0, XA1},
                 EpOdd{(u16*)(S + S_R), (u16*)(S + S_LORA)});
      return;
    }
    if (q == 6) { phase_mix(p, 3, XA0, 0, nullptr, MTOT); return; }
    gemm_tiles(smem, (const u16*)(W + W_V), D, D, MTOT / 128, 8, 0, APlain{XA0, D}, EpStore{(u16*)(S + S_V), D, D, 0, 0});
    gemm_tiles<AShift, EpLora, false>(smem, (const u16*)(W + W_W1), D, D, MTOT / 128, 3, 136, AShift{H, p.in[I_XMIX], 24},
               EpLora{(u16*)(S + S_LORA)});
    return;
  }
  if (layer == 1 && q > 7) q -= 3;
  const float* modl = MOD + (size_t)layer * 5 * 9216;
  const float* ng = p.in[I_NORMG] + (size_t)layer * 3 * D;
  const bool first = (layer == 0);
  const float* xin_lat = X; const float* xin_ctx = X + (size_t)MLAT * D;
  if (q == 0) {
    if (first) phase_norm(p, p.in[I_X], p.in[I_CTX], ng, modl, 0, MTOT);
    else phase_norm(p, xin_lat, xin_ctx, ng, modl, 0, MTOT, 0, 8, 0.5f, xin_lat, xin_ctx, MOD);

    return;
  }
  if (q == 1) {
    gemm256(smem, (const u16*)(W + W_WI0), D, D, MTOT / 256, 44, APlain{H, D}, EpSwiglu{(u16*)(S + S_ACT)});
    return;
  }
  if (q == 2) {
    if (first)
      gemm_tiles<APlain, EpResid, true, false>(smem, (const u16*)(W + W_WO0), FF, FF, MTOT / 128, 8, 0, APlain{(const u16*)(S + S_ACT), FF},
                 EpResid{p.in[I_X], p.in[I_CTX], X, modl, 2, 0.5f}, (float*)(S + S_PART));
    else
      gemm_tiles<APlain, EpResid, true, false>(smem, (const u16*)(W + W_WO0), FF, FF, MTOT / 128, 8, 0, APlain{(const u16*)(S + S_ACT), FF},
                 EpResid{xin_lat, xin_ctx, X, modl, 2, 0.5f}, (float*)(S + S_PART));
    return;
  }
  if (q == 3) {
    if (first) phase_norm(p, xin_lat, xin_ctx, ng + D, modl, 1, MTOT, 0, 2, 0.5f, p.in[I_X], p.in[I_CTX], modl);
    else phase_norm(p, xin_lat, xin_ctx, ng + D, modl, 1, MTOT, 0, 2, 0.5f, xin_lat, xin_ctx, modl);
    return;
  }
  if (layer == 0) {
    if (q == 4) {
      gemm_tiles(smem, (const u16*)(W + W_IN), D, D, MTOT / 128, 33, 0, APlain{H, D},
                 EpEvenIn{(u16*)(S + S_P), (const float*)(p.ws + OFF_LBT)});
      return;
    }
    if (q == 5) {
      for (int u = blockIdx.x; u < 256; u += gridDim.x) {
        if (u < 128) hgrn_chunk_unit(p, u, smem);
        else ssd_chunk_unit(p, u - 128, smem);
      }
      return;
    }
    if (q == 6) { phase_even_finish(p, MTOT); return; }
    if (q == 7) {
      gemm_tiles<APlain, EpResid, true, false>(smem, (const u16*)(W + W_OUT), D, D, MTOT / 128, 8, 0, APlain{H, D},
                 EpResid{xin_lat, xin_ctx, X, modl, 5, 1.0f}, (float*)(S + S_PART));
      return;
    }
    if (q == 8) { phase_norm(p, xin_lat, xin_ctx, ng + 2 * D, modl, 2, MTOT, 0, 5, 1.0f, xin_lat, xin_ctx, modl); return; }
    if (q == 9) {
      gemm256(smem, (const u16*)(W + W_WI1), D, D, MTOT / 256, 44, APlain{H, D}, EpSwiglu{(u16*)(S + S_ACT)});
      return;
    }
    if (q == 10) {
      gemm_tiles<APlain, EpResid, true, false>(smem, (const u16*)(W + W_WO1), FF, FF, MTOT / 128, 8, 0, APlain{(const u16*)(S + S_ACT), FF},
                 EpResid{xin_lat, xin_ctx, X, modl, 8, 0.5f}, (float*)(S + S_PART));
      return;
    }
  } else {
    if (q == 4) {
      gemm_tiles<AShift, EpOdd, false>(smem, (const u16*)(W + W_R), D, D, MTOT / 128, 27, 0, AShift{H, p.in[I_XMIX], 0},
                 EpOdd{(u16*)(S + S_R), (u16*)(S + S_LORA)});
      return;
    }
    if (q == 5) {
      for (int u = blockIdx.x; u < 256; u += gridDim.x) odd_scan_unit(p, u, smem);
      return;
    }
    if (q == 6) {
      gemm_tiles(smem, (const u16*)(W + W_G2), 128, 128, MLAT / 128, 8, 0, APlain{(const u16*)(S + S_LORA) + 256, LLD},
                 EpStore{(u16*)(S + S_G), D, D, 0, 0});
      return;
    }
    if (q == 7) { phase_odd_finish(p, MLAT); return; }
    if (q == 8) {
      gemm256(smem, (const u16*)(W + W_O), D, D, MLAT / 256, 8, APlain{H, D},
              EpResid{xin_lat, xin_ctx, X, modl, 5, 1.0f});
      return;
    }
    if (q == 9) { phase_norm(p, xin_lat, xin_ctx, ng + 2 * D, modl, 2, MLAT); return; }
    if (q == 10) {
      gemm256(smem, (const u16*)(W + W_WI1), D, D, MLAT / 256, 44, APlain{H, D}, EpSwiglu{(u16*)(S + S_ACT)});
      return;
    }
    if (q == 11) {
      gemm256(smem, (const u16*)(W + W_WO1), FF, FF, MLAT / 256, 8, APlain{(const u16*)(S + S_ACT), FF},
              EpResid{xin_lat, xin_ctx, X, modl, 8, 0.5f});
      return;
    }
  }
}

__global__ void __launch_bounds__(256, 2) mega_kernel(Params p, int ph_lo, int ph_hi) {
  __shared__ __attribute__((aligned(16))) char smem[65536];
  cg::grid_group grid = cg::this_grid();
  XcdBarrier gb = xcd_barrier_post((unsigned*)(p.ws + OFF_BAR));
  if (ph_hi > 1000) grid.sync();
#ifdef PH_ONLY
  run_phase(p, PH_ONLY, smem);
  if (ph_lo < 0) grid.sync();
#else
#ifndef PROBE_DUP
#define PROBE_DUP -1
#endif
#define PHASE(k) if (ph_lo <= (k) && (k) < ph_hi) { run_phase(p, (k), smem); if ((k) == PROBE_DUP) { __syncthreads(); run_phase(p, (k), smem); } if ((k) + 1 < ph_hi) xcd_barrier(gb); }
  PHASE(0) PHASE(1) PHASE(2) PHASE(3) PHASE(4) PHASE(5) PHASE(6) PHASE(7) PHASE(8) PHASE(9) PHASE(10) PHASE(11) PHASE(12)
  PHASE(13) PHASE(14) PHASE(15) PHASE(16) PHASE(17) PHASE(18) PHASE(19) PHASE(20) PHASE(21) PHASE(22) PHASE(23) PHASE(24) PHASE(25) PHASE(26) PHASE(27) PHASE(28) PHASE(29)
#endif
}

#ifndef N_SPLIT
#define N_SPLIT 0
#endif

extern "C" void kernel_launch(void* const* d_in, const int* in_sizes, int n_in, void* d_out, int out_size, void* d_ws,
                              size_t ws_size, hipStream_t stream) {
  static int grid_blocks = 0;
  if (!grid_blocks) {
    int dev = 0, cus = 0, per_cu = 0;
    hipGetDevice(&dev);
    hipDeviceGetAttribute(&cus, hipDeviceAttributeMultiprocessorCount, dev);
    hipOccupancyMaxActiveBlocksPerMultiprocessor(&per_cu, mega_kernel, 256, 0);
    if (per_cu > 2) per_cu = 2;
    if (per_cu < 1) per_cu = 1;
    grid_blocks = cus * per_cu;
  }
  Params p{};
  for (int i = 0; i < 38; ++i) p.in[i] = (const float*)d_in[i];
  p.out = (float*)d_out;
  p.ws = (char*)d_ws;
#if N_SPLIT
  for (int ph = 0; ph < NPHASE; ++ph) {
    int lo = ph, hi = ph + 1;
    void* args[] = {&p, &lo, &hi};
    hipError_t e = hipLaunchCooperativeKernel((void*)mega_kernel, dim3(grid_blocks), dim3(256), args, 0, stream);
    if (e != hipSuccess) fprintf(stderr, "cooperative launch failed: %s (grid %d)\n", hipGetErrorString(e), grid_blocks);
  }
#else
  hipMemsetAsync((char*)d_ws + OFF_BAR, 0, XCD_BAR_WORDS * 4, stream);
  int lo = 0, hi = NPHASE;
  void* args[] = {&p, &lo, &hi};
  hipError_t e = hipLaunchCooperativeKernel((void*)mega_kernel, dim3(grid_blocks), dim3(256), args, 0, stream);
  if (e != hipSuccess) fprintf(stderr, "cooperative launch failed: %s (grid %d)\n", hipGetErrorString(e), grid_blocks);
#endif
}
```

```cpp
#include <hip/hip_runtime.h>
#include <hip/hip_cooperative_groups.h>
#include <cstdio>
namespace cg = cooperative_groups;

#define DEV __device__ __forceinline__
typedef unsigned short u16;
typedef __attribute__((ext_vector_type(8))) short bf16x8;
typedef __attribute__((ext_vector_type(4))) short bf16x4;
typedef __attribute__((ext_vector_type(2))) short bf16x2;
typedef __attribute__((ext_vector_type(4))) float f32x4;

constexpr int D = 1024;
constexpr int MLAT = 16384;
constexpr int MCTX = 1024;
constexpr int MTOT = 17408;
constexpr int FF = 2816;
constexpr int PLD = 4112;
constexpr int LLD = 384;

constexpr size_t OFF_X = 0;
constexpr size_t OFF_MOD = 71303168;
constexpr size_t OFF_W = OFF_MOD + 368640;
constexpr size_t W_WI0 = 0, W_WI1 = 11534336, W_WO0 = 23068672, W_WO1 = 28835840, W_MIX = 34603008;
constexpr size_t W_IN = W_MIX, W_OUT = W_MIX + 8650752;
constexpr size_t W_R = W_MIX, W_K = W_MIX + 2097152, W_V = W_MIX + 4194304;
constexpr size_t W_W1 = W_MIX + 6291456, W_A1 = W_W1 + 262144, W_G1 = W_A1 + 262144;
constexpr size_t W_O = W_G1 + 262144;
constexpr size_t W_W2 = W_O + 2097152, W_A2 = W_W2 + 262144, W_G2 = W_A2 + 262144;
constexpr size_t WSIZE = 46000128;
constexpr size_t OFF_S = OFF_W + WSIZE;
constexpr size_t SZ_H = 35651584;
constexpr size_t S_H = 0;
constexpr size_t S_ACT = SZ_H;
constexpr size_t S_O1 = SZ_H, S_P = 2 * SZ_H;
constexpr size_t S_Y1 = SZ_H, S_R = 2 * SZ_H, S_K = 3 * SZ_H, S_V = 4 * SZ_H, S_G = 5 * SZ_H;
constexpr size_t S_LORA = 6 * SZ_H;
constexpr size_t S_BON = S_LORA + 13369344;
constexpr size_t OFF_BAR = OFF_W + 45400064;
constexpr size_t OFF_LBT = OFF_BAR + 16384;
constexpr size_t S_PART = 4 * SZ_H;
constexpr size_t S_F = 2 * SZ_H + 143163392;

struct Params {
  const float* in[38];
  float* out;
  char* ws;
};

enum { I_X = 0, I_C, I_CTX, I_CCTX, I_ADAW, I_ADAB, I_NORMG, I_WI, I_WO, I_FINALG, I_LB, I_EVIN, I_EVOUT,
       I_HGRNG, I_CONVW, I_CONVB, I_DTB, I_ALOG, I_SSDD, I_SSDG, I_XMIX, I_WR, I_WK, I_WV, I_WOO, I_W0, I_W1,
       I_W2, I_A0, I_A1, I_A2, I_G1, I_G2, I_KK, I_KA, I_RK, I_LNW, I_LNB };

DEV float bf2f(short v) { return __uint_as_float(((unsigned)(unsigned short)v) << 16); }
DEV short f2bf(float f) { return __builtin_bit_cast(short, (__bf16)f); }
DEV float sigm(float x) { return __builtin_amdgcn_rcpf(1.0f + __expf(-x)); }
DEV float silu(float x) { return x * sigm(x); }

template <int CTRL>
DEV float dppf(float v) {
  return __int_as_float(__builtin_amdgcn_update_dpp(0, __float_as_int(v), CTRL, 0xF, 0xF, true));
}
DEV float red4(float v) { v += dppf<0xB1>(v); v += dppf<0x4E>(v); return v; }
DEV float red8(float v) { v = red4(v); v += dppf<0x141>(v); return v; }
DEV float red16(float v) { v = red8(v); v += dppf<0x140>(v); return v; }
DEV float red64(float v) {
  v = red16(v);
  v += __shfl_xor(v, 16);
  v += __shfl_xor(v, 32);
  return v;
}


#define XB_TMO      128
#define XB_XCNT(j)  (256  + 64 * (j))
#define XB_XSUB(j)  (1280 + 64 * (j))
#define XB_XGEN(j)  (2304 + 64 * (j))
#define XB_TOP      3328
#define XB_TOPGEN   3392
#define XCD_BAR_WORDS 3456
#define XB_SPIN_CAP (1u << 20)
DEV unsigned xb_ld(unsigned* p) { return __hip_atomic_load(p, __ATOMIC_RELAXED, __HIP_MEMORY_SCOPE_AGENT); }
DEV unsigned xb_add(unsigned* p, unsigned v) { return __hip_atomic_fetch_add(p, v, __ATOMIC_RELAXED, __HIP_MEMORY_SCOPE_AGENT); }
DEV unsigned xb_xcc_id() { return (unsigned)__builtin_amdgcn_s_getreg((3 << 11) | 20) & 0xFu; }
#define XB_SPIN(cond, bar) do { unsigned _sp = 0; while (cond) { __builtin_amdgcn_s_sleep(1); \
    if ((++_sp & 255u) == 0u) { if (xb_ld(&(bar)[XB_TMO])) break; if (_sp > XB_SPIN_CAP) { atomicAdd(&(bar)[XB_TMO], 1u); break; } } } } while (0)
struct XcdBarrier { unsigned* bar; unsigned x; unsigned nloc; unsigned nx; };
DEV XcdBarrier xcd_barrier_post(unsigned* bar) {
  XcdBarrier b; b.bar = bar; b.x = xb_xcc_id(); b.nloc = 0u; b.nx = 0u;
  if (threadIdx.x == 0) (void)xb_add(&bar[XB_XCNT(b.x)], 1u);
  return b;
}
DEV void xcd_barrier_complete(unsigned* bar, unsigned x, unsigned& nloc, unsigned& nx) {
  const unsigned G = gridDim.x;
  unsigned sum, cnt, mine, sp = 0u;
  for (;;) {
    sum = 0u; cnt = 0u; mine = 0u;
#pragma unroll
    for (unsigned j = 0; j < 16; ++j) { const unsigned c = xb_ld(&bar[XB_XCNT(j)]); sum += c; cnt += (c > 0u) ? 1u : 0u; mine = (j == x) ? c : mine; }
    if (sum == G) break;
    __builtin_amdgcn_s_sleep(1);
    if ((++sp & 255u) == 0u) { if (xb_ld(&bar[XB_TMO])) break; if (sp > XB_SPIN_CAP) { atomicAdd(&bar[XB_TMO], 1u); break; } }
  }
  nloc = mine > 0u ? mine : 1u; nx = cnt > 0u ? cnt : 1u;
}
DEV void xcd_barrier(XcdBarrier& b) {
  asm volatile("s_waitcnt vmcnt(0)" ::: "memory");
  __syncthreads();
  if (threadIdx.x == 0) {
    unsigned* bar = b.bar;
    __builtin_amdgcn_s_waitcnt(0);
    if (b.nloc == 0u) xcd_barrier_complete(bar, b.x, b.nloc, b.nx);
    const unsigned nloc = b.nloc, nx = b.nx;
    const unsigned old = xb_add(&bar[XB_XSUB(b.x)], 1u);
    const unsigned gen = old / nloc;
    if (old + 1u == (gen + 1u) * nloc) {
      __builtin_amdgcn_fence(__ATOMIC_RELEASE, "agent");
      asm volatile("s_waitcnt vmcnt(0)" ::: "memory");
      const unsigned og = xb_add(&bar[XB_TOP], 1u);
      const unsigned tg = og / nx;
      if (og + 1u == (tg + 1u) * nx) xb_add(&bar[XB_TOPGEN], 1u);
      else XB_SPIN(xb_ld(&bar[XB_TOPGEN]) == tg, bar);
      __builtin_amdgcn_fence(__ATOMIC_ACQUIRE, "agent");
      xb_add(&bar[XB_XGEN(b.x)], 1u);
      asm volatile("s_waitcnt vmcnt(0)" ::: "memory");
    } else {
      XB_SPIN(xb_ld(&bar[XB_XGEN(b.x)]) == gen, bar);
      __builtin_amdgcn_fence(__ATOMIC_ACQUIRE, "agent");
      asm volatile("s_waitcnt vmcnt(0)" ::: "memory");
    }
  }
  __syncthreads();
}

DEV const float* xrow_ptr(const float* lat, const float* ctx, int row) {
  return row < MLAT ? lat + (size_t)row * D : ctx + (size_t)(row - MLAT) * D;
}
DEV int mod_idx(int row) { return row < MLAT ? (row >> 12) : 4; }

struct APlain {
  const u16* A; int lda;
  DEV bf16x8 operator()(int row, int k, int tn) const { return *(const bf16x8*)(A + (size_t)row * lda + k); }
};

struct AShift {
  const u16* H; const float* mixbase; int tn_off;
  DEV bf16x8 operator()(int row, int k, int tn0) const {
    const int tn = tn0 + tn_off;
    const int jsel = tn < 24 ? (tn < 8 ? 0 : (tn < 16 ? 2 : 3)) : (tn == 24 ? 1 : (tn == 25 ? 4 : 5));
    const float* mix = mixbase + jsel * D;
    bf16x8 own = *(const bf16x8*)(H + (size_t)row * D + k);
    const int q = k >> 8;
    int nrow; bool valid;
    if (row < MLAT) {
      const int t = row & 4095, cx = t & 63, ry = t >> 6;
      if (q == 0) { valid = cx > 0; nrow = row - 1; }
      else if (q == 1) { valid = cx < 63; nrow = row + 1; }
      else if (q == 2) { valid = ry > 0; nrow = row - 64; }
      else { valid = ry < 63; nrow = row + 64; }
    } else {
      const int t = (row - MLAT) & 255;
      if ((q & 1) == 0) { valid = t > 0; nrow = row - 1; }
      else { valid = t < 255; nrow = row + 1; }
    }
    bf16x8 nb = *(const bf16x8*)(H + (size_t)(valid ? nrow : row) * D + k);
    if (!valid) nb = bf16x8{0, 0, 0, 0, 0, 0, 0, 0};
    const float4 m0 = *(const float4*)(mix + k), m1 = *(const float4*)(mix + k + 4);
    const float mm[8] = {m0.x, m0.y, m0.z, m0.w, m1.x, m1.y, m1.z, m1.w};
    bf16x8 o;
#pragma unroll
    for (int e = 0; e < 8; ++e) {
      const float a = bf2f(own[e]), sft = bf2f(nb[e]);
      o[e] = f2bf(a + (sft - a) * mm[e]);
    }
    return o;
  }
};

DEV float act_apply(float v, int act) {
  if (act == 1) return 2.0f * sigm(2.0f * v) - 1.0f;
  if (act == 2) return sigm(v);
  return v;
}
DEV void store16_bf16(u16* dst, const f32x4 (&a)[4], int act) {
  bf16x8 o0, o1;
#pragma unroll
  for (int j = 0; j < 4; ++j) {
    o0[j] = f2bf(act_apply(a[0][j], act)); o0[4 + j] = f2bf(act_apply(a[1][j], act));
    o1[j] = f2bf(act_apply(a[2][j], act)); o1[4 + j] = f2bf(act_apply(a[3][j], act));
  }
  *(bf16x8*)dst = o0;
  *(bf16x8*)(dst + 8) = o1;
}

struct EpStore {
  u16* C; int ldc; int ncols; int act; int coloff;
  DEV void operator()(f32x4 (&acc)[4][4], int rbase, int cbase, int lane) const {
    const int fr = lane & 15, fq = lane >> 4;
    const int col = cbase + fq * 16;
    if (col < ncols) {
#pragma unroll
      for (int m = 0; m < 4; ++m) {
        const int row = rbase + m * 16 + fr;
        store16_bf16(C + (size_t)row * ldc + coloff + col, acc[m], act);
      }
    }
  }
};

struct EpEvenIn {
  u16* P; const float* lbt;
  DEV void operator()(f32x4 (&acc)[4][4], int rbase, int cbase, int lane) const {
    const int fr = lane & 15, fq = lane >> 4;
    const int col = cbase + fq * 16;
    if (col >= PLD) return;
    const int mode = col < 512 ? 1 : ((col >= 1024 && col < 2048) ? 2 : 0);
    float oml[16];
    if (mode == 2) {
#pragma unroll
      for (int n = 0; n < 4; ++n) {
        const float4 l4 = *(const float4*)(lbt + (col - 1024) + n * 4);
        oml[n * 4 + 0] = 1.0f - l4.x; oml[n * 4 + 1] = 1.0f - l4.y; oml[n * 4 + 2] = 1.0f - l4.z; oml[n * 4 + 3] = 1.0f - l4.w;
      }
    } else {
#pragma unroll
      for (int e = 0; e < 16; ++e) oml[e] = 0.f;
    }
#pragma unroll
    for (int m = 0; m < 4; ++m) {
      const int row = rbase + m * 16 + fr;
      bf16x8 o0, o1;
#pragma unroll
      for (int n = 0; n < 4; ++n)
#pragma unroll
        for (int j = 0; j < 4; ++j) {
          float v = acc[m][n][j];
          if (mode == 1) v = silu(v);
          else if (mode == 2) v = oml[n * 4 + j] * sigm(-v);
          const short h = f2bf(v);
          if (n < 2) o0[n * 4 + j] = h; else o1[(n - 2) * 4 + j] = h;
        }
      *(bf16x8*)(P + (size_t)row * PLD + col) = o0;
      *(bf16x8*)(P + (size_t)row * PLD + col + 8) = o1;
    }
  }
};

struct EpOdd {
  u16* RKV; u16* LORA;
  DEV void operator()(f32x4 (&acc)[4][4], int rbase, int cbase, int lane) const {
    const int fr = lane & 15, fq = lane >> 4;
    const int tn = cbase >> 7;
    if (tn < 24) {
      u16* C = RKV + (size_t)(tn >> 3) * (SZ_H / 2);
      const int col = (cbase & 1023) + fq * 16;
#pragma unroll
      for (int m = 0; m < 4; ++m) store16_bf16(C + (size_t)(rbase + m * 16 + fr) * D + col, acc[m], 0);
    } else {
      const int act = tn == 24 ? 1 : (tn == 25 ? 0 : 2);
      const int col = (tn - 24) * 128 + (cbase & 127) + fq * 16;
#pragma unroll
      for (int m = 0; m < 4; ++m) store16_bf16(LORA + (size_t)(rbase + m * 16 + fr) * LLD + col, acc[m], act);
    }
  }
};

struct EpSwiglu {
  u16* ACT;
  DEV void operator()(f32x4 (&acc)[4][4], int rbase, int cbase, int lane) const {
    const int fr = lane & 15, fq = lane >> 4;
    const int col = (cbase >> 1) + fq * 8;
#pragma unroll
    for (int m = 0; m < 4; ++m) {
      const int row = rbase + m * 16 + fr;
      bf16x8 o;
#pragma unroll
      for (int nn = 0; nn < 2; ++nn)
#pragma unroll
        for (int j = 0; j < 4; ++j) o[nn * 4 + j] = f2bf(silu(acc[m][nn][j]) * acc[m][nn + 2][j]);
      *(bf16x8*)(ACT + (size_t)row * FF + col) = o;
    }
  }
};

struct EpResid {
  const float* xlat; const float* xctx; float* xout; const float* modl; int gidx; float scale;
  DEV void operator()(f32x4 (&acc)[4][4], int rbase, int cbase, int lane) const {
    const int fr = lane & 15, fq = lane >> 4;
    const int col = cbase + fq * 16;
    const float* gate = modl + (size_t)mod_idx(rbase) * 9216 + gidx * 1024 + col;
    float4 gv[4];
#pragma unroll
    for (int n = 0; n < 4; ++n) {
      gv[n] = *(const float4*)(gate + n * 4);
      gv[n].x *= scale; gv[n].y *= scale; gv[n].z *= scale; gv[n].w *= scale;
    }
#pragma unroll
    for (int m = 0; m < 4; ++m) {
      const int row = rbase + m * 16 + fr;
      const float* xi = xrow_ptr(xlat, xctx, row) + col;
      float* xo = xout + (size_t)row * D + col;
#pragma unroll
      for (int n = 0; n < 4; ++n) {
        float4 v = *(const float4*)(xi + n * 4);
        v.x += gv[n].x * acc[m][n][0]; v.y += gv[n].y * acc[m][n][1];
        v.z += gv[n].z * acc[m][n][2]; v.w += gv[n].w * acc[m][n][3];
        *(float4*)(xo + n * 4) = v;
      }
    }
  }
};

struct ATwo {
  const u16* A0; const u16* A1;
  DEV bf16x8 operator()(int row, int k, int tn) const { return *(const bf16x8*)((tn < 8 ? A0 : A1) + (size_t)row * D + k); }
};

struct EpLora {
  u16* LORA;
  DEV void operator()(f32x4 (&acc)[4][4], int rbase, int cbase, int lane) const {
    const int fr = lane & 15, fq = lane >> 4;
    const int tn = cbase >> 7;
    const int act = tn == 0 ? 1 : (tn == 1 ? 0 : 2);
    const int col = cbase + fq * 16;
#pragma unroll
    for (int m = 0; m < 4; ++m) store16_bf16(LORA + (size_t)(rbase + m * 16 + fr) * LLD + col, acc[m], act);
  }
};

DEV void phase_mix(const Params& p, int j0, u16* dst0, int j1, u16* dst1, int nrows) {
  const u16* H = (const u16*)(p.ws + OFF_S + S_H);
  const int lane = threadIdx.x & 63;
  const int gw = blockIdx.x * 4 + (threadIdx.x >> 6), stride = gridDim.x * 4;
  const int q = lane >> 4;
  for (int row = gw; row < nrows; row += stride) {
    int nrow; bool valid;
    if (row < MLAT) {
      const int t = row & 4095, cx = t & 63, ry = t >> 6;
      if (q == 0) { valid = cx > 0; nrow = row - 1; }
      else if (q == 1) { valid = cx < 63; nrow = row + 1; }
      else if (q == 2) { valid = ry > 0; nrow = row - 64; }
      else { valid = ry < 63; nrow = row + 64; }
    } else {
      const int t = (row - MLAT) & 255;
      if ((q & 1) == 0) { valid = t > 0; nrow = row - 1; }
      else { valid = t < 255; nrow = row + 1; }
    }
#pragma unroll
    for (int hh = 0; hh < 2; ++hh) {
      const int c = lane * 16 + hh * 8;
      const bf16x8 own = *(const bf16x8*)(H + (size_t)row * D + c);
      bf16x8 nb = *(const bf16x8*)(H + (size_t)(valid ? nrow : row) * D + c);
      if (!valid) nb = bf16x8{0, 0, 0, 0, 0, 0, 0, 0};
      float m0[8], m1[8];
      *(float4*)(m0) = *(const float4*)(p.in[I_XMIX] + j0 * D + c); *(float4*)(m0 + 4) = *(const float4*)(p.in[I_XMIX] + j0 * D + c + 4);
      bf16x8 o0, o1;
#pragma unroll
      for (int e = 0; e < 8; ++e) {
        const float a = bf2f(own[e]), sft = bf2f(nb[e]);
        o0[e] = f2bf(a + (sft - a) * m0[e]);
      }
      *(bf16x8*)(dst0 + (size_t)row * D + c) = o0;
      if (dst1) {
        *(float4*)(m1) = *(const float4*)(p.in[I_XMIX] + j1 * D + c); *(float4*)(m1 + 4) = *(const float4*)(p.in[I_XMIX] + j1 * D + c + 4);
#pragma unroll
        for (int e = 0; e < 8; ++e) {
          const float a = bf2f(own[e]), sft = bf2f(nb[e]);
          o1[e] = f2bf(a + (sft - a) * m1[e]);
        }
        *(bf16x8*)(dst1 + (size_t)row * D + c) = o1;
      }
    }
  }
}

DEV int keyB(int r) { return (((r >> 4) & 3) << 1) | ((r >> 1) & 1); }

#ifndef GM
#define GM 8
#endif
template <class AL, bool DEEP>
DEV void gemm_kloop(char* smem, const u16* __restrict__ Bt, int ldb, const AL& al, int row0, int col0, int tn,
                    int kt_lo, int nk, f32x4 (&acc)[4][4]) {
  const int tid = threadIdx.x, lane = tid & 63, wave = tid >> 6;
  const int wm = wave >> 1, wn = wave & 1, fr = lane & 15, fq = lane >> 4;
  const int r0 = tid >> 3, c0 = tid & 7;
  const int kB = ((fr >> 2) << 1) | ((fr >> 1) & 1);
#pragma unroll
  for (int m = 0; m < 4; ++m)
#pragma unroll
    for (int n = 0; n < 4; ++n) acc[m][n] = f32x4{0.f, 0.f, 0.f, 0.f};
  bf16x8 ra0[4], rb0[4], ra1[4], rb1[4];
#define GLOAD(RA, RB, kt)                                                                          \
  {                                                                                                \
    const int kk_ = (kt_lo + (kt)) * 64 + c0 * 8;                                                  \
    _Pragma("unroll") for (int i = 0; i < 4; ++i) {                                                \
      RA[i] = al(row0 + r0 + i * 32, kk_, tn);                                                     \
      RB[i] = *(const bf16x8*)(Bt + (size_t)(col0 + r0 + i * 32) * ldb + kk_);                     \
    }                                                                                              \
  }
#define LWRITE(RA, RB, stage)                                                                      \
  {                                                                                                \
    _Pragma("unroll") for (int i = 0; i < 4; ++i) {                                                \
      const int r_ = r0 + i * 32;                                                                  \
      *(bf16x8*)(smem + (stage) * 32768 + r_ * 128 + ((c0 ^ (r_ & 7)) << 4)) = RA[i];             \
      *(bf16x8*)(smem + (stage) * 32768 + 16384 + r_ * 128 + ((c0 ^ keyB(r_)) << 4)) = RB[i];     \
    }                                                                                              \
  }
#define COMPUTE(stage)                                                                             \
  {                                                                                                \
    const char* sa_ = smem + (stage) * 32768;                                                      \
    const char* sb_ = sa_ + 16384;                                                                 \
    _Pragma("unroll") for (int ks = 0; ks < 2; ++ks) {                                             \
      bf16x8 af[4], bfr[4];                                                                        \
      const int c_ = ks * 4 + fq;                                                                  \
      _Pragma("unroll") for (int m = 0; m < 4; ++m)                                                \
        af[m] = *(const bf16x8*)(sa_ + (wm * 64 + m * 16 + fr) * 128 + ((c_ ^ (fr & 7)) << 4));    \
      _Pragma("unroll") for (int n = 0; n < 4; ++n)                                                \
        bfr[n] = *(const bf16x8*)(sb_ + (wn * 64 + (fr >> 2) * 16 + n * 4 + (fr & 3)) * 128 + ((c_ ^ kB) << 4)); \
      _Pragma("unroll") for (int m = 0; m < 4; ++m)                                                \
        _Pragma("unroll") for (int n = 0; n < 4; ++n)                                              \
          acc[m][n] = __builtin_amdgcn_mfma_f32_16x16x32_bf16(bfr[n], af[m], acc[m][n], 0, 0, 0);  \
    }                                                                                              \
  }
  if (DEEP) {
    GLOAD(ra0, rb0, 0);
    if (nk > 1) GLOAD(ra1, rb1, 1);
    LWRITE(ra0, rb0, 0);
    __syncthreads();
    if (nk > 2) GLOAD(ra0, rb0, 2);
    for (int kt = 0; kt < nk; kt += 2) {
      COMPUTE(0);
      if (kt + 1 < nk) LWRITE(ra1, rb1, 1);
      __syncthreads();
      if (kt + 3 < nk) GLOAD(ra1, rb1, kt + 3);
      if (kt + 1 < nk) {
        COMPUTE(1);
        if (kt + 2 < nk) LWRITE(ra0, rb0, 0);
        __syncthreads();
        if (kt + 4 < nk) GLOAD(ra0, rb0, kt + 4);
      }
    }
  } else {
    GLOAD(ra0, rb0, 0);
    LWRITE(ra0, rb0, 0);
    __syncthreads();
    for (int kt = 0; kt < nk; kt += 2) {
      if (kt + 1 < nk) GLOAD(ra0, rb0, kt + 1);
      COMPUTE(0);
      if (kt + 1 < nk) LWRITE(ra0, rb0, 1);
      __syncthreads();
      if (kt + 1 < nk) {
        if (kt + 2 < nk) GLOAD(ra0, rb0, kt + 2);
        COMPUTE(1);
        if (kt + 2 < nk) LWRITE(ra0, rb0, 0);
        __syncthreads();
      }
    }
  }
#undef GLOAD
#undef LWRITE
#undef COMPUTE
}

template <class AL, class EP, bool DEEP = true, bool SPLIT = false>
DEV void gemm_tiles(char* smem, const u16* __restrict__ Bt, int ldb, int K, int nM, int nN, int tile_off,
                    const AL& al, const EP& ep, float* part = nullptr) {
  const int tid = threadIdx.x, lane = tid & 63, wave = tid >> 6;
  const int wm = wave >> 1, wn = wave & 1, fr = lane & 15, fq = lane >> 4;
  const int ntiles = nM * nN;
  const int nslots = gridDim.x >> 3, xcd = blockIdx.x & 7;
  const int per = (ntiles + 7) >> 3;
  int slot = (int)(blockIdx.x >> 3) - (tile_off % nslots);
  if (slot < 0) slot += nslots;
  const int nkfull = K >> 6;
  const int full = SPLIT ? (per / nslots) * nslots : per;
  for (int L = slot; L < full; L += nslots) {
    const int gidx = xcd * per + L;
    if (gidx >= ntiles) break;
    const int grp = gidx / (GM * nN), rem = gidx - grp * (GM * nN);
    const int gm = min(GM, nM - grp * GM);
    const int tn = rem / gm, tm = grp * GM + (rem - tn * gm);
    const int row0 = tm * 128, col0 = tn * 128;
    f32x4 acc[4][4];
    gemm_kloop<AL, DEEP>(smem, Bt, ldb, al, row0, col0, tn, 0, nkfull, acc);
    ep(acc, row0 + wm * 64, col0 + wn * 64, lane);
  }
  if (SPLIT) {
    const int ntail = per - full;
    if (ntail > 0) {
      const int S = nslots / ntail;
      if (slot < ntail * S) {
        const int ti = slot / S, ksl = slot - ti * S;
        const int gidx = xcd * per + full + ti;
        if (gidx < ntiles) {
          const int kt_lo = (ksl * nkfull) / S, nk = ((ksl + 1) * nkfull) / S - kt_lo;
          const int grp = gidx / (GM * nN), rem = gidx - grp * (GM * nN);
          const int gm = min(GM, nM - grp * GM);
          const int tn = rem / gm, tm = grp * GM + (rem - tn * gm);
          f32x4 acc[4][4];
          gemm_kloop<AL, false>(smem, Bt, ldb, al, tm * 128, tn * 128, tn, kt_lo, nk, acc);
          float* dst = part + ((size_t)((xcd * ntail + ti) * S + ksl) << 14);
#pragma unroll
          for (int m = 0; m < 4; ++m)
#pragma unroll
            for (int n = 0; n < 4; ++n)
              *(f32x4*)(dst + (wm * 64 + m * 16 + fr) * 128 + wn * 64 + fq * 16 + n * 4) = acc[m][n];
        }
      }
    }
  }
}

template <class AL, class EP>
DEV void gemm256(char* smem, const u16* __restrict__ Bt, int ldb, int K, int nM, int nN, const AL& al, const EP& ep) {
  const int tid = threadIdx.x, lane = tid & 63, wave = tid >> 6;
  const int wm = wave >> 1, wn = wave & 1, fr = lane & 15, fq = lane >> 4;
  const int ntiles = nM * nN;
  const int nslots = gridDim.x >> 3, xcd = blockIdx.x & 7;
  const int per = (ntiles + 7) >> 3;
  const int slot = blockIdx.x >> 3;
  const int nk = K >> 5;
  const int lr = tid >> 2, lc = tid & 3;
  const int kA = (0x1320 >> (((fr >> 2) & 3) * 4)) & 3;
  const int kBb = (0x1320 >> ((fr >> 2) * 4)) & 3;
  for (int L = slot; L < per; L += nslots) {
    const int gidx = xcd * per + L;
    if (gidx >= ntiles) break;
    const int grp = gidx / (2 * nN), rem = gidx - grp * (2 * nN);
    const int gm = min(2, nM - grp * 2);
    const int tn = rem / gm, tm = grp * 2 + (rem - tn * gm);
    const int row0 = tm * 256, col0 = tn * 128;
    f32x4 acc[2][4][4];
#pragma unroll
    for (int h = 0; h < 2; ++h)
#pragma unroll
      for (int m = 0; m < 4; ++m)
#pragma unroll
        for (int n = 0; n < 4; ++n) acc[h][m][n] = f32x4{0.f, 0.f, 0.f, 0.f};
    bf16x8 ra0[4], rb0[2], ra1[4], rb1[2];
#define GLOAD2(ra, rb, kt)                                                                         \
  {                                                                                                \
    const int kk_ = (kt) * 32 + lc * 8;                                                            \
    _Pragma("unroll") for (int i = 0; i < 4; ++i) ra[i] = al(row0 + lr + i * 64, kk_, tn);         \
    _Pragma("unroll") for (int i = 0; i < 2; ++i)                                                  \
      rb[i] = *(const bf16x8*)(Bt + (size_t)(col0 + lr + i * 64) * ldb + kk_);                     \
  }
#define LWRITE2(ra, rb, stage)                                                                     \
  {                                                                                                \
    _Pragma("unroll") for (int i = 0; i < 4; ++i) {                                                \
      const int r_ = lr + i * 64;                                                                  \
      const int ka_ = (0x1320 >> (((r_ >> 2) & 3) * 4)) & 3;                                       \
      *(bf16x8*)(smem + (stage) * 24576 + r_ * 64 + ((lc ^ ka_) << 4)) = ra[i];                    \
    }                                                                                              \
    _Pragma("unroll") for (int i = 0; i < 2; ++i) {                                                \
      const int r_ = lr + i * 64;                                                                  \
      *(bf16x8*)(smem + (stage) * 24576 + 16384 + r_ * 64 + ((lc ^ ((0x1320 >> (((r_ >> 4) & 3) * 4)) & 3)) << 4)) = rb[i]; \
    }                                                                                              \
  }
#define COMPUTE2(stage)                                                                            \
  {                                                                                                \
    const char* sa_ = smem + (stage) * 24576;                                                      \
    const char* sb_ = sa_ + 16384;                                                                 \
    bf16x8 bfr[4];                                                                                 \
    _Pragma("unroll") for (int n = 0; n < 4; ++n)                                                  \
      bfr[n] = *(const bf16x8*)(sb_ + (wn * 64 + (fr >> 2) * 16 + n * 4 + (fr & 3)) * 64 + ((fq ^ kBb) << 4)); \
    _Pragma("unroll") for (int h = 0; h < 2; ++h) {                                                \
      bf16x8 af[4];                                                                                \
      _Pragma("unroll") for (int m = 0; m < 4; ++m)                                                \
        af[m] = *(const bf16x8*)(sa_ + (wm * 128 + h * 64 + m * 16 + fr) * 64 + ((fq ^ kA) << 4)); \
      _Pragma("unroll") for (int m = 0; m < 4; ++m)                                                \
        _Pragma("unroll") for (int n = 0; n < 4; ++n)                                              \
          acc[h][m][n] = __builtin_amdgcn_mfma_f32_16x16x32_bf16(bfr[n], af[m], acc[h][m][n], 0, 0, 0); \
    }                                                                                              \
  }
    GLOAD2(ra0, rb0, 0);
    if (nk > 1) GLOAD2(ra1, rb1, 1);
    LWRITE2(ra0, rb0, 0);
    __syncthreads();
    if (nk > 2) GLOAD2(ra0, rb0, 2);
    for (int kt = 0; kt < nk; kt += 2) {
      COMPUTE2(0);
      if (kt + 1 < nk) LWRITE2(ra1, rb1, 1);
      __syncthreads();
      if (kt + 3 < nk) GLOAD2(ra1, rb1, kt + 3);
      if (kt + 1 < nk) {
        COMPUTE2(1);
        if (kt + 2 < nk) LWRITE2(ra0, rb0, 0);
        __syncthreads();
        if (kt + 4 < nk) GLOAD2(ra0, rb0, kt + 4);
      }
    }
    ep(acc[0], row0 + wm * 128, col0 + wn * 64, lane);
    ep(acc[1], row0 + wm * 128 + 64, col0 + wn * 64, lane);
  }
#undef GLOAD2
#undef LWRITE2
#undef COMPUTE2
}

DEV void transpose_job(char* smem, const float* __restrict__ src, int K, int Nsrc, u16* __restrict__ dst, int dst_rows,
                       int perm, int& tile_off) {
  float* tile = (float*)smem;
  const int tid = threadIdx.x;
  const int G = gridDim.x;
  const int nkt = K >> 6, nnt = dst_rows >> 6;
  const int ntiles = nkt * nnt;
  int start = (int)blockIdx.x - (tile_off % G);
  if (start < 0) start += G;
  for (int t = start; t < ntiles; t += G) {
    const int kt = t % nkt, nt = t / nkt;
    const int k0 = kt * 64, n0 = nt * 64;
#pragma unroll
    for (int i = 0; i < 4; ++i) {
      const int id = tid + i * 256;
      const int kk = id >> 4, n4 = (id & 15) * 4;
      float4 v = {0.f, 0.f, 0.f, 0.f};
      if (n0 + n4 < Nsrc) v = *(const float4*)(src + (size_t)(k0 + kk) * Nsrc + n0 + n4);
      tile[kk * 65 + n4 + 0] = v.x; tile[kk * 65 + n4 + 1] = v.y;
      tile[kk * 65 + n4 + 2] = v.z; tile[kk * 65 + n4 + 3] = v.w;
    }
    __syncthreads();
#pragma unroll
    for (int i = 0; i < 2; ++i) {
      const int id = tid + i * 256;
      const int nn = id >> 3, k8 = (id & 7) * 8;
      bf16x8 o;
#pragma unroll
      for (int e = 0; e < 8; ++e) o[e] = f2bf(tile[(k8 + e) * 65 + nn]);
      int n = n0 + nn, R = n;
      if (perm) {
        const int up = n >= FF, g = up ? n - FF : n;
        const int w = g & 31, e = w & 7;
        R = (g >> 5) * 64 + (w >> 3) * 16 + ((e >> 2) + (up ? 2 : 0)) * 4 + (e & 3);
      }
      *(bf16x8*)(dst + (size_t)R * K + k0 + k8) = o;
    }
    __syncthreads();
  }
  tile_off += ntiles;
}

DEV void phase_prep(const Params& p, int layer, char* smem) {
  char* W = p.ws + OFF_W;
  int off = 0;
  for (int h = 0; h < 2; ++h) {
    transpose_job(smem, p.in[I_WI] + (size_t)(layer * 2 + h) * D * (2 * FF), D, 2 * FF,
                  (u16*)(W + (h ? W_WI1 : W_WI0)), 2 * FF, 1, off);
    transpose_job(smem, p.in[I_WO] + (size_t)(layer * 2 + h) * FF * D, FF, D, (u16*)(W + (h ? W_WO1 : W_WO0)), D, 0, off);
  }
  if (layer == 0) {
    transpose_job(smem, p.in[I_EVIN], D, PLD, (u16*)(W + W_IN), 4224, 0, off);
    transpose_job(smem, p.in[I_EVOUT], D, D, (u16*)(W + W_OUT), D, 0, off);
    {
      float* LBT = (float*)(p.ws + OFF_LBT);
      for (int i = blockIdx.x * 256 + threadIdx.x; i < 1024; i += gridDim.x * 256) {
        const float* lg = p.in[I_LB];
        const float l0 = lg[i], l1 = lg[1024 + i], l2 = lg[2048 + i];
        const float mx = fmaxf(l0, fmaxf(l1, l2));
        const float e0 = __expf(l0 - mx), e1 = __expf(l1 - mx), e2 = __expf(l2 - mx);
        LBT[i] = e0 / (e0 + e1 + e2);
      }
    }
    float* sc = (float*)smem;
    float* red = (float*)(smem + 20480);
    const int tid = threadIdx.x;
    __syncthreads();
    for (int i = tid; i < 5 * D; i += 256) {
      const int s = i >> 10, k = i & 1023;
      const float v = s < 4 ? p.in[I_C][s * D + k] : p.in[I_CCTX][k];
      sc[i] = silu(v);
    }
    __syncthreads();
    const int G = gridDim.x;
    int start = (int)blockIdx.x - (off % G);
    if (start < 0) start += G;
    float* MOD = (float*)(p.ws + OFF_MOD);
    for (int u = start; u < 288; u += G) {
      const int l = u / 144, j0 = (u % 144) * 64;
      const int jj = tid & 63, kg = tid >> 6;
      const float* w = p.in[I_ADAW] + (size_t)l * D * 9216 + j0 + jj;
      float a0 = 0.f, a1 = 0.f, a2 = 0.f, a3 = 0.f, a4 = 0.f;
#pragma unroll 8
      for (int k = kg * 256; k < kg * 256 + 256; ++k) {
        const float wv = w[(size_t)k * 9216];
        a0 += sc[k] * wv; a1 += sc[1024 + k] * wv; a2 += sc[2048 + k] * wv; a3 += sc[3072 + k] * wv; a4 += sc[4096 + k] * wv;
      }
      float* rr = red + (kg * 64 + jj) * 5;
      rr[0] = a0; rr[1] = a1; rr[2] = a2; rr[3] = a3; rr[4] = a4;
      __syncthreads();
      for (int i = tid; i < 320; i += 256) {
        const int s = i / 64, j = i % 64;
        const float v = red[(0 * 64 + j) * 5 + s] + red[(1 * 64 + j) * 5 + s] + red[(2 * 64 + j) * 5 + s] + red[(3 * 64 + j) * 5 + s];
        MOD[(size_t)(l * 5 + s) * 9216 + j0 + j] = v + p.in[I_ADAB][l * 9216 + j0 + j];
      }
      __syncthreads();
    }
  } else {
    transpose_job(smem, p.in[I_WR], D, D, (u16*)(W + W_R), D, 0, off);
    transpose_job(smem, p.in[I_WK], D, D, (u16*)(W + W_K), D, 0, off);
    transpose_job(smem, p.in[I_WV], D, D, (u16*)(W + W_V), D, 0, off);
    transpose_job(smem, p.in[I_WOO], D, D, (u16*)(W + W_O), D, 0, off);
    for (int d = 0; d < 2; ++d) {
      transpose_job(smem, p.in[I_W1] + (size_t)d * D * 64, D, 64, (u16*)(W + W_W1) + (size_t)d * 64 * D, 64, 0, off);
      transpose_job(smem, p.in[I_A1] + (size_t)d * D * 64, D, 64, (u16*)(W + W_A1) + (size_t)d * 64 * D, 64, 0, off);
      transpose_job(smem, p.in[I_W2] + (size_t)d * 64 * D, 64, D, (u16*)(W + W_W2) + (size_t)d * D * 64, D, 0, off);
      transpose_job(smem, p.in[I_A2] + (size_t)d * 64 * D, 64, D, (u16*)(W + W_A2) + (size_t)d * D * 64, D, 0, off);
    }
    transpose_job(smem, p.in[I_G1], D, 128, (u16*)(W + W_G1), 128, 0, off);
    transpose_job(smem, p.in[I_G2], 128, D, (u16*)(W + W_G2), D, 0, off);
  }
}

DEV void phase_norm(const Params& p, const float* xlat, const float* xctx, const float* g, const float* modl,
                    int slot, int nrows, int fix_nM = 0, int fix_gidx = 0, float fix_scale = 0.f,
                    const float* fix_lat = nullptr, const float* fix_ctx = nullptr, const float* fix_modl = nullptr) {
  u16* H = (u16*)(p.ws + OFF_S + S_H);
  const int lane = threadIdx.x & 63;
  const int gw = blockIdx.x * 4 + (threadIdx.x >> 6), stride = gridDim.x * 4;
  for (int row = gw; row < nrows; row += stride) {
    const float4* src = (const float4*)xrow_ptr(xlat, xctx, row);
    const float* mm = modl + (size_t)mod_idx(row) * 9216 + slot * 3 * 1024;
    float4 v[4];
    float ss = 0.f;
#pragma unroll
    for (int i = 0; i < 4; ++i) {
      v[i] = src[lane + i * 64];
      if (fix_nM) {
        const int nN_ = 8, nslots_ = gridDim.x >> 3;
        const int per_ = (fix_nM * nN_ + 7) >> 3, full_ = (per_ / nslots_) * nslots_, ntail_ = per_ - full_;
        if (ntail_ > 0) {
          const int S_ = nslots_ / ntail_;
          const int c = (lane + i * 64) * 4, tn_ = c >> 7, tm_ = row >> 7;
          const int grp_ = tm_ / GM, gm_ = min(GM, fix_nM - grp_ * GM);
          const int gidx_ = grp_ * (GM * nN_) + tn_ * gm_ + (tm_ - grp_ * GM);
          const int xcd_ = gidx_ / per_, L_ = gidx_ - xcd_ * per_;
          if (L_ >= full_) {
            const float* part = (const float*)(p.ws + OFF_S + S_PART) + ((size_t)((xcd_ * ntail_ + (L_ - full_)) * S_) << 14) +
                                (row & 127) * 128 + (c & 127);
            float4 sum = {0.f, 0.f, 0.f, 0.f};
            for (int sl = 0; sl < S_; ++sl) {
              const float4 pv = *(const float4*)(part + ((size_t)sl << 14));
              sum.x += pv.x; sum.y += pv.y; sum.z += pv.z; sum.w += pv.w;
            }
            const float4 g4 = *(const float4*)(fix_modl + (size_t)mod_idx(row) * 9216 + fix_gidx * 1024 + c);
            const float4 xr = *(const float4*)(xrow_ptr(fix_lat, fix_ctx, row) + c);
            v[i].x = xr.x + fix_scale * g4.x * sum.x; v[i].y = xr.y + fix_scale * g4.y * sum.y;
            v[i].z = xr.z + fix_scale * g4.z * sum.z; v[i].w = xr.w + fix_scale * g4.w * sum.w;
            *(float4*)((float*)(p.ws + OFF_X) + (size_t)row * D + c) = v[i];
          }
        }
      }
      ss += v[i].x * v[i].x + v[i].y * v[i].y + v[i].z * v[i].z + v[i].w * v[i].w;
    }
    ss = red64(ss);
    const float rstd = rsqrtf(ss * (1.0f / 1024.0f) + 1e-6f);
#pragma unroll
    for (int i = 0; i < 4; ++i) {
      const int c = (lane + i * 64) * 4;
      const float4 gg = *(const float4*)(g + c);
      const float4 sh = *(const float4*)(mm + c);
      const float4 scl = *(const float4*)(mm + 1024 + c);
      bf16x4 o;
      o[0] = f2bf(v[i].x * rstd * gg.x * (1.0f + scl.x) + sh.x);
      o[1] = f2bf(v[i].y * rstd * gg.y * (1.0f + scl.y) + sh.y);
      o[2] = f2bf(v[i].z * rstd * gg.z * (1.0f + scl.z) + sh.z);
      o[3] = f2bf(v[i].w * rstd * gg.w * (1.0f + scl.w) + sh.w);
      *(bf16x4*)(H + (size_t)row * D + c) = o;
    }
  }
}

DEV void phase_final(const Params& p) {
  const float* X = (const float*)(p.ws + OFF_X);
  const float* g = p.in[I_FINALG];
  const int lane = threadIdx.x & 63;
  const int gw = blockIdx.x * 4 + (threadIdx.x >> 6), stride = gridDim.x * 4;
  for (int row = gw; row < MLAT; row += stride) {
    const float4* src = (const float4*)(X + (size_t)row * D);
    float4 v[4];
    float ss = 0.f;
#pragma unroll
    for (int i = 0; i < 4; ++i) {
      v[i] = src[lane + i * 64];
      ss += v[i].x * v[i].x + v[i].y * v[i].y + v[i].z * v[i].z + v[i].w * v[i].w;
    }
    ss = red64(ss);
    const float rstd = rsqrtf(ss * (1.0f / 1024.0f) + 1e-6f);
#pragma unroll
    for (int i = 0; i < 4; ++i) {
      const int c = (lane + i * 64) * 4;
      const float4 gg = *(const float4*)(g + c);
      float4 o;
      o.x = v[i].x * rstd * gg.x; o.y = v[i].y * rstd * gg.y; o.z = v[i].z * rstd * gg.z; o.w = v[i].w * rstd * gg.w;
      *(float4*)(p.out + (size_t)row * D + c) = o;
    }
  }
}

DEV int scan_row(int s, int b, int d) {
  if (s < 256) return MLAT + b * 256 + (d ? 255 - s : s);
  const int s2 = s - 256;
  return b * 4096 + (d ? 4095 - s2 : s2);
}

DEV bf16x8 ld8(const u16* P, int row, int col) { return *(const bf16x8*)(P + (size_t)row * PLD + col); }

DEV void even_scan_unit(const Params& p, int unit, char* smem) {
  const u16* P = (const u16*)(p.ws + OFF_S + S_P);
  float* dec = (float*)smem;
  float* kin = dec + 2048;
  float* qo = kin + 2048;
  float* vin = qo + 2048;
  float* cw = vin + 512;
  const int tid = threadIdx.x, lane = tid & 63;
  const bool ssd = unit >= 128;
  const int u = unit & 127;
  const int b = u >> 5;
  int d, colbase;
  int h = 0, vq = 0;
  int head = 0, ph = 0, grp = 0;
  if (!ssd) { h = (u >> 3) & 3; d = (u >> 2) & 1; vq = u & 3; colbase = h * 128 + vq * 32; }
  else { head = (u >> 2) & 7; d = (u >> 1) & 1; ph = u & 1; grp = head >> 2; colbase = 512 + head * 64 + ph * 32; }
  u16* O = (u16*)(p.ws + OFF_S + (d ? S_O1 : S_H));

  const int tok = tid >> 4, part = tid & 15;
  float lbv[8];
  float dtb = 0.f, aneg = 0.f;
  if (!ssd) {
    const float* lg = p.in[I_LB];
#pragma unroll
    for (int e = 0; e < 8; ++e) {
      const int c = d * 512 + h * 128 + part * 8 + e;
      const float l0 = lg[c], l1 = lg[1024 + c], l2 = lg[2048 + c];
      const float mx = fmaxf(l0, fmaxf(l1, l2));
      const float e0 = __expf(l0 - mx), e1 = __expf(l1 - mx), e2 = __expf(l2 - mx);
      lbv[e] = e0 / (e0 + e1 + e2);
    }
  } else {
    dtb = p.in[I_DTB][d * 8 + head];
    aneg = -__expf(p.in[I_ALOG][d * 8 + head]);
    for (int i = tid; i < 288; i += 256) {
      int c;
      if (i < 128) c = 512 + grp * 128 + i;
      else if (i < 256) c = 768 + grp * 128 + (i - 128);
      else c = head * 64 + ph * 32 + (i - 256);
      cw[i * 4 + 0] = p.in[I_CONVW][c];
      cw[i * 4 + 1] = p.in[I_CONVW][1024 + c];
      cw[i * 4 + 2] = p.in[I_CONVW][2048 + c];
      cw[i * 4 + 3] = p.in[I_CONVB][c];
    }
  }
  const int kp = lane & 15, vg = tid >> 4;
  float S[8][2];
#pragma unroll
  for (int a = 0; a < 8; ++a) { S[a][0] = 0.f; S[a][1] = 0.f; }

  const bf16x8 z8 = {0, 0, 0, 0, 0, 0, 0, 0};
  bf16x8 q0 = z8, q1 = z8, q2 = z8, q3 = z8, q4 = z8, q5 = z8, q6 = z8, q7 = z8, q8 = z8;
  short dtraw = 0, dtraw2 = 0;
  const int tok2 = (tid >> 2) & 15, part2 = tid & 3;
#define EV_ISSUE(c)                                                                              \
  {                                                                                              \
    const int row = scan_row((c) * 16 + tok, b, d);                                              \
    const int row2 = scan_row((c) * 16 + tok2, b, d);                                            \
    if (!ssd) {                                                                                  \
      q0 = ld8(P, row, 1024 + d * 512 + h * 128 + part * 8);                                     \
      q1 = ld8(P, row, h * 128 + part * 8);                                                      \
      q2 = ld8(P, row2, 512 + h * 128 + vq * 32 + part2 * 8);                                    \
    } else {                                                                                     \
      const bool lat = row < MLAT;                                                               \
      const int tpos = lat ? (row & 4095) : ((row - MLAT) & 255);                                \
      const int T = lat ? 4096 : 256;                                                            \
      const bool hm = tpos > 0, hp = tpos < T - 1;                                               \
      const int rm = hm ? row - 1 : row, rp = hp ? row + 1 : row;                                \
      const int cB = 3584 + grp * 128 + part * 8, cC = 3840 + grp * 128 + part * 8;              \
      q0 = ld8(P, rm, cB); q1 = ld8(P, row, cB); q2 = ld8(P, rp, cB);                            \
      q3 = ld8(P, rm, cC); q4 = ld8(P, row, cC); q5 = ld8(P, rp, cC);                            \
      if (!hm) { q0 = z8; q3 = z8; }                                                             \
      if (!hp) { q2 = z8; q5 = z8; }                                                             \
      dtraw = (short)P[(size_t)row * PLD + 4096 + d * 8 + head];                                 \
      const bool lat2 = row2 < MLAT;                                                             \
      const int tp2 = lat2 ? (row2 & 4095) : ((row2 - MLAT) & 255);                              \
      const int T2 = lat2 ? 4096 : 256;                                                          \
      const bool hm2 = tp2 > 0, hp2 = tp2 < T2 - 1;                                              \
      const int cX = 3072 + head * 64 + ph * 32 + part2 * 8;                                     \
      q6 = ld8(P, hm2 ? row2 - 1 : row2, cX); q7 = ld8(P, row2, cX); q8 = ld8(P, hp2 ? row2 + 1 : row2, cX); \
      if (!hm2) q6 = z8;                                                                         \
      if (!hp2) q8 = z8;                                                                         \
      dtraw2 = (short)P[(size_t)row2 * PLD + 4096 + d * 8 + head];                               \
    }                                                                                            \
  }
  __syncthreads();
  EV_ISSUE(0);
  const int NCH = (256 + 4096) / 16;
  for (int c = 0; c < NCH; ++c) {
    if (!ssd) {
      float fv[8], kv[8], qv[8];
#pragma unroll
      for (int e = 0; e < 8; ++e) {
        const float z = bf2f(q0[e]);
        const float sg = sigm(z);
        fv[e] = lbv[e] + (1.0f - lbv[e]) * sg;
        kv[e] = (1.0f - lbv[e]) * (1.0f - sg);
        qv[e] = silu(bf2f(q1[e]));
      }
      float* d0 = dec + tok * 128 + part * 8;
      float* k0 = kin + tok * 128 + part * 8;
      float* qq = qo + tok * 128 + part * 8;
      *(float4*)d0 = float4{fv[0], fv[1], fv[2], fv[3]}; *(float4*)(d0 + 4) = float4{fv[4], fv[5], fv[6], fv[7]};
      *(float4*)k0 = float4{kv[0], kv[1], kv[2], kv[3]}; *(float4*)(k0 + 4) = float4{kv[4], kv[5], kv[6], kv[7]};
      *(float4*)qq = float4{qv[0], qv[1], qv[2], qv[3]}; *(float4*)(qq + 4) = float4{qv[4], qv[5], qv[6], qv[7]};
      if (tid < 64) {
        float* vv = vin + (tid >> 2) * 32 + (tid & 3) * 8;
#pragma unroll
        for (int e = 0; e < 8; ++e) vv[e] = bf2f(q2[e]);
      }
    } else {
      const float dtv = bf2f(dtraw) + dtb;
      const float dt = dtv > 20.f ? dtv : __logf(1.0f + __expf(dtv));
      const float dc = __expf(dt * aneg);
      float bv[8], cv[8];
#pragma unroll
      for (int e = 0; e < 8; ++e) {
        const float4 wb = *(const float4*)(cw + (part * 8 + e) * 4);
        const float4 wc = *(const float4*)(cw + (128 + part * 8 + e) * 4);
        bv[e] = silu(wb.x * bf2f(q0[e]) + wb.y * bf2f(q1[e]) + wb.z * bf2f(q2[e]) + wb.w);
        cv[e] = silu(wc.x * bf2f(q3[e]) + wc.y * bf2f(q4[e]) + wc.z * bf2f(q5[e]) + wc.w);
      }
      float* d0 = dec + tok * 128 + part * 8;
      float* k0 = kin + tok * 128 + part * 8;
      float* qq = qo + tok * 128 + part * 8;
      *(float4*)d0 = float4{dc, dc, dc, dc}; *(float4*)(d0 + 4) = float4{dc, dc, dc, dc};
      *(float4*)k0 = float4{bv[0], bv[1], bv[2], bv[3]}; *(float4*)(k0 + 4) = float4{bv[4], bv[5], bv[6], bv[7]};
      *(float4*)qq = float4{cv[0], cv[1], cv[2], cv[3]}; *(float4*)(qq + 4) = float4{cv[4], cv[5], cv[6], cv[7]};
      if (tid < 64) {
        const float dtv2 = bf2f(dtraw2) + dtb;
        const float dt2 = dtv2 > 20.f ? dtv2 : __logf(1.0f + __expf(dtv2));
        float* vv = vin + (tid >> 2) * 32 + (tid & 3) * 8;
#pragma unroll
        for (int e = 0; e < 8; ++e) {
          const float4 wx = *(const float4*)(cw + (256 + (tid & 3) * 8 + e) * 4);
          vv[e] = dt2 * silu(wx.x * bf2f(q6[e]) + wx.y * bf2f(q7[e]) + wx.z * bf2f(q8[e]) + wx.w);
        }
      }
    }
    __syncthreads();
    if (c + 1 < NCH) EV_ISSUE(c + 1);
    float ok0 = 0.f, ok1 = 0.f;
#pragma unroll 4
    for (int t = 0; t < 16; ++t) {
      const float4 da = *(const float4*)(dec + t * 128 + kp * 8), db = *(const float4*)(dec + t * 128 + kp * 8 + 4);
      const float4 ka = *(const float4*)(kin + t * 128 + kp * 8), kb = *(const float4*)(kin + t * 128 + kp * 8 + 4);
      const float4 qa = *(const float4*)(qo + t * 128 + kp * 8), qb = *(const float4*)(qo + t * 128 + kp * 8 + 4);
      const float2 vv = *(const float2*)(vin + t * 32 + vg * 2);
      const float dd[8] = {da.x, da.y, da.z, da.w, db.x, db.y, db.z, db.w};
      const float kk[8] = {ka.x, ka.y, ka.z, ka.w, kb.x, kb.y, kb.z, kb.w};
      const float qq[8] = {qa.x, qa.y, qa.z, qa.w, qb.x, qb.y, qb.z, qb.w};
      float o0 = 0.f, o1 = 0.f;
#pragma unroll
      for (int a = 0; a < 8; ++a) {
        S[a][0] = dd[a] * S[a][0] + kk[a] * vv.x;
        S[a][1] = dd[a] * S[a][1] + kk[a] * vv.y;
        o0 += S[a][0] * qq[a];
        o1 += S[a][1] * qq[a];
      }
      o0 = red16(o0); o1 = red16(o1);
      ok0 = (kp == t) ? o0 : ok0;
      ok1 = (kp == t) ? o1 : ok1;
    }
    {
      const int row = scan_row(c * 16 + kp, b, d);
      bf16x2 ov; ov[0] = f2bf(ok0); ov[1] = f2bf(ok1);
      *(bf16x2*)(O + (size_t)row * D + colbase + vg * 2) = ov;
    }
    __syncthreads();
  }
}

#define MFMA16(a, b, c) __builtin_amdgcn_mfma_f32_16x16x32_bf16(a, b, c, 0, 0, 0)
DEV bf16x8 lds8(const u16* q) { return *(const bf16x8*)q; }

DEV void hgrn_chunk_unit(const Params& p, int u, char* smem) {
  const u16* P = (const u16*)(p.ws + OFF_S + S_P);
  u16* QH = (u16*)smem;
  u16* KH = QH + 4352;
  u16* QG = KH + 4352;
  u16* KTT = QG + 4352;
  u16* VT = KTT + 5120;
  u16* PB = VT + 1280;
  u16* ST = PB + 1280;
  float* TOT = (float*)(ST + 4352);
  float* DEC = TOT + 512;
  u16* RAWF = QG;
  u16* RAWQ = RAWF + 4096;
  const int tid = threadIdx.x, lane = tid & 63, wave = tid >> 6, fr = lane & 15, fq = lane >> 4;
  const int b = u >> 5, h = (u >> 3) & 3, d = (u >> 2) & 1, vq = u & 3;
  const int colbase = h * 128 + vq * 32;
  u16* O = (u16*)(p.ws + OFF_S + (d ? S_O1 : S_H));
  const int kp = tid & 63, g = tid >> 6, k0 = kp * 2;
  __syncthreads();
  for (int i = tid; i < 4352 / 2; i += 256) ((unsigned*)ST)[i] = 0u;
  f32x4 Sacc[2][2];
#pragma unroll
  for (int a = 0; a < 2; ++a)
#pragma unroll
    for (int c2 = 0; c2 < 2; ++c2) Sacc[a][c2] = f32x4{0.f, 0.f, 0.f, 0.f};
  bf16x8 pf0, pf1, pq0, pq1, pv;
  const int tokA = tid >> 4, k8 = (tid & 15) * 8;
  const int tokv = (tid >> 2) & 31, v8 = (tid & 3) * 8;
#define HG_ISSUE(c)                                                                         \
  {                                                                                         \
    const int r0_ = scan_row((c) * 32 + tokA, b, d), r1_ = scan_row((c) * 32 + tokA + 16, b, d); \
    pf0 = ld8(P, r0_, 1024 + d * 512 + h * 128 + k8); pf1 = ld8(P, r1_, 1024 + d * 512 + h * 128 + k8); \
    pq0 = ld8(P, r0_, h * 128 + k8); pq1 = ld8(P, r1_, h * 128 + k8);                       \
    pv = ld8(P, scan_row((c) * 32 + tokv, b, d), 512 + h * 128 + vq * 32 + v8);             \
  }
  HG_ISSUE(0);
  const int NCH = (256 + 4096) / 32;
  for (int c = 0; c < NCH; ++c) {
    *(bf16x8*)(RAWF + tokA * 128 + k8) = pf0; *(bf16x8*)(RAWF + (tokA + 16) * 128 + k8) = pf1;
    *(bf16x8*)(RAWQ + tokA * 128 + k8) = pq0; *(bf16x8*)(RAWQ + (tokA + 16) * 128 + k8) = pq1;
    if (tid < 128) {
#pragma unroll
      for (int e = 0; e < 8; ++e) VT[(v8 + e) * 40 + tokv] = (u16)pv[e];
    }
    __syncthreads();
    if (c + 1 < NCH) HG_ISSUE(c + 1);
    float qv[2][8], kv[2][8], cm[2][8];
    float cum0 = 1.f, cum1 = 1.f;
#pragma unroll
    for (int t = 0; t < 8; ++t) {
      const int tok = g * 8 + t;
      const bf16x2 rf = *(const bf16x2*)(RAWF + tok * 128 + k0);
      const bf16x2 rq2 = *(const bf16x2*)(RAWQ + tok * 128 + k0);
      kv[0][t] = bf2f(rf[0]); kv[1][t] = bf2f(rf[1]);
      qv[0][t] = bf2f(rq2[0]); qv[1][t] = bf2f(rq2[1]);
      cum0 *= 1.0f - kv[0][t]; cum1 *= 1.0f - kv[1][t];
      cm[0][t] = cum0; cm[1][t] = cum1;
    }
    *(float2*)(TOT + g * 128 + k0) = float2{cum0, cum1};
    __syncthreads();
    {
      const float2 ta = *(const float2*)(TOT + k0), tb = *(const float2*)(TOT + 128 + k0);
      const float2 tc = *(const float2*)(TOT + 256 + k0), td = *(const float2*)(TOT + 384 + k0);
      const float tt[2][4] = {{ta.x, tb.x, tc.x, td.x}, {ta.y, tb.y, tc.y, td.y}};
      bf16x8 ktv[2];
      float e0s[2], e1s[2];
#pragma unroll
      for (int cc = 0; cc < 2; ++cc) {
        const float pre = (g > 0 ? tt[cc][0] : 1.f) * (g > 1 ? tt[cc][1] : 1.f) * (g > 2 ? tt[cc][2] : 1.f);
        e0s[cc] = 1.0f;
        e1s[cc] = tt[cc][0] * tt[cc][1] * tt[cc][2] * tt[cc][3];
        const float off = pre;
#pragma unroll
        for (int t = 0; t < 8; ++t) {
          const float eq = cm[cc][t] * off, ek = __builtin_amdgcn_rcpf(eq);
          qv[cc][t] = qv[cc][t] * eq;
          kv[cc][t] = kv[cc][t] * ek;
          ktv[cc][t] = f2bf(kv[cc][t] * e1s[cc]);
        }
      }
#pragma unroll
      for (int t = 0; t < 8; ++t) {
        const int tok = g * 8 + t;
        bf16x2 o;
        o[0] = f2bf(kv[0][t]); o[1] = f2bf(kv[1][t]);
        *(bf16x2*)(KH + tok * 136 + k0) = o;
        o[0] = f2bf(qv[0][t]); o[1] = f2bf(qv[1][t]);
        *(bf16x2*)(QG + tok * 136 + k0) = o;
      }
      *(bf16x8*)(KTT + k0 * 40 + g * 8) = ktv[0];
      *(bf16x8*)(KTT + (k0 + 1) * 40 + g * 8) = ktv[1];
      if (g == 0) *(float2*)(DEC + k0) = float2{e0s[0] * e1s[0], e0s[1] * e1s[1]};
    }
    __syncthreads();
    if (wave < 3) {
      const int lt = wave ? 1 : 0, st = wave == 2 ? 1 : 0;
      f32x4 acc = {0.f, 0.f, 0.f, 0.f};
#pragma unroll
      for (int ks = 0; ks < 4; ++ks)
        acc = MFMA16(lds8(QG + (lt * 16 + fr) * 136 + ks * 32 + fq * 8), lds8(KH + (st * 16 + fr) * 136 + ks * 32 + fq * 8), acc);
#pragma unroll
      for (int j = 0; j < 4; ++j) {
        const int l = lt * 16 + fq * 4 + j, s2 = st * 16 + fr;
        PB[l * 40 + s2] = (u16)f2bf(s2 <= l ? acc[j] : 0.f);
      }
    } else {
#pragma unroll
      for (int j = 0; j < 4; ++j) PB[(fq * 4 + j) * 40 + 16 + fr] = 0;
    }
    __syncthreads();
    {
      const int lt = wave >> 1, vt = wave & 1;
      f32x4 acc = {0.f, 0.f, 0.f, 0.f};
#pragma unroll
      for (int ks = 0; ks < 4; ++ks)
        acc = MFMA16(lds8(QG + (lt * 16 + fr) * 136 + ks * 32 + fq * 8), lds8(ST + (vt * 16 + fr) * 136 + ks * 32 + fq * 8), acc);
      acc = MFMA16(lds8(PB + (lt * 16 + fr) * 40 + fq * 8), lds8(VT + (vt * 16 + fr) * 40 + fq * 8), acc);
#pragma unroll
      for (int j = 0; j < 4; ++j) {
        const int row = scan_row(c * 32 + lt * 16 + fq * 4 + j, b, d);
        O[(size_t)row * D + colbase + vt * 16 + fr] = (u16)f2bf(acc[j]);
      }
#pragma unroll
      for (int a = 0; a < 2; ++a) {
        const int kt = wave * 2 + a;
        const float4 dc = *(const float4*)(DEC + kt * 16 + fq * 4);
        const bf16x8 af = lds8(KTT + (kt * 16 + fr) * 40 + fq * 8);
#pragma unroll
        for (int v2 = 0; v2 < 2; ++v2) {
          Sacc[a][v2][0] *= dc.x; Sacc[a][v2][1] *= dc.y; Sacc[a][v2][2] *= dc.z; Sacc[a][v2][3] *= dc.w;
          Sacc[a][v2] = MFMA16(af, lds8(VT + (v2 * 16 + fr) * 40 + fq * 8), Sacc[a][v2]);
        }
      }
    }
    __syncthreads();
#pragma unroll
    for (int a = 0; a < 2; ++a)
#pragma unroll
      for (int v2 = 0; v2 < 2; ++v2) {
        bf16x4 o;
#pragma unroll
        for (int j = 0; j < 4; ++j) o[j] = f2bf(Sacc[a][v2][j]);
        *(bf16x4*)(ST + (v2 * 16 + fr) * 136 + (wave * 2 + a) * 16 + fq * 4) = o;
      }
  }
  __syncthreads();
#undef HG_ISSUE
}

DEV void ssd_chunk_unit(const Params& p, int u, char* smem) {
  const u16* P = (const u16*)(p.ws + OFF_S + S_P);
  const u16* F = (const u16*)(p.ws + OFF_S + S_F);
  u16* CM = (u16*)smem;
  u16* BM = CM + 4352;
  u16* V1 = BM + 4352;
  u16* V2 = V1 + 1280;
  u16* PB = V2 + 1280;
  u16* ST = PB + 1280;
  float* LG = (float*)(ST + 4352);
  float* BC = LG + 32;
  const int tid = threadIdx.x, lane = tid & 63, wave = tid >> 6, fr = lane & 15, fq = lane >> 4;
  const int b = u >> 5, head = (u >> 2) & 7, d = (u >> 1) & 1, ph = u & 1, grp = head >> 2;
  const int colbase = 512 + head * 64 + ph * 32;
  u16* O = (u16*)(p.ws + OFF_S + (d ? S_O1 : S_H));
  const float dtb = p.in[I_DTB][d * 8 + head];
  const float aneg = -__expf(p.in[I_ALOG][d * 8 + head]);
  __syncthreads();
  for (int i = tid; i < 4352 / 2; i += 256) ((unsigned*)ST)[i] = 0u;
  f32x4 Sacc[2][2];
#pragma unroll
  for (int a = 0; a < 2; ++a)
#pragma unroll
    for (int c2 = 0; c2 < 2; ++c2) Sacc[a][c2] = f32x4{0.f, 0.f, 0.f, 0.f};
  const int tok = tid >> 3, part = tid & 7, n16 = part * 16;
  bf16x8 b0, b1, c0, c1;
  bf16x4 x0;
  short dtraw;
#define SD_ISSUE(c)                                                                         \
  {                                                                                         \
    const int row = scan_row((c) * 32 + tok, b, d);                                         \
    const u16* fr_ = F + (size_t)row * D;                                                   \
    b0 = *(const bf16x8*)(fr_ + 512 + grp * 128 + n16); b1 = *(const bf16x8*)(fr_ + 512 + grp * 128 + n16 + 8); \
    c0 = *(const bf16x8*)(fr_ + 768 + grp * 128 + n16); c1 = *(const bf16x8*)(fr_ + 768 + grp * 128 + n16 + 8); \
    x0 = *(const bf16x4*)(fr_ + head * 64 + ph * 32 + part * 4);                            \
    dtraw = (short)P[(size_t)row * PLD + 4096 + d * 8 + head];                              \
  }
  SD_ISSUE(0);
  __syncthreads();
  const int NCH = (256 + 4096) / 32;
  for (int c = 0; c < NCH; ++c) {
    const float dtv = bf2f(dtraw) + dtb;
    const float dt = dtv > 20.f ? dtv : __logf(1.0f + __expf(dtv));
    float dtx[4];
    *(bf16x8*)(BM + tok * 136 + n16) = b0; *(bf16x8*)(BM + tok * 136 + n16 + 8) = b1;
    *(bf16x8*)(CM + tok * 136 + n16) = c0; *(bf16x8*)(CM + tok * 136 + n16 + 8) = c1;
    {
#pragma unroll
      for (int e = 0; e < 4; ++e) { dtx[e] = dt * bf2f(x0[e]); V1[(part * 4 + e) * 40 + tok] = (u16)f2bf(dtx[e]); }
    }
    if (part == 0) LG[tok] = dt * aneg;
    __syncthreads();
    if (c + 1 < NCH) SD_ISSUE(c + 1);
    float bt = 0.f, tot = 0.f;
#pragma unroll
    for (int i4 = 0; i4 < 8; ++i4) {
      const float4 v4 = *(const float4*)(LG + i4 * 4);
      const float vv[4] = {v4.x, v4.y, v4.z, v4.w};
#pragma unroll
      for (int e = 0; e < 4; ++e) {
        tot += vv[e];
        bt += (i4 * 4 + e <= tok) ? vv[e] : 0.f;
      }
    }
    if (part == 0) BC[tok] = bt;
    {
      const float e2 = __expf(tot - bt);
#pragma unroll
      for (int e = 0; e < 4; ++e) V2[(part * 4 + e) * 40 + tok] = (u16)f2bf(e2 * dtx[e]);
    }
    const float decS = __expf(tot);
    __syncthreads();
    if (wave < 3) {
      const int lt = wave ? 1 : 0, st = wave == 2 ? 1 : 0;
      f32x4 acc = {0.f, 0.f, 0.f, 0.f};
#pragma unroll
      for (int ks = 0; ks < 4; ++ks)
        acc = MFMA16(lds8(CM + (lt * 16 + fr) * 136 + ks * 32 + fq * 8), lds8(BM + (st * 16 + fr) * 136 + ks * 32 + fq * 8), acc);
      const float4 bl = *(const float4*)(BC + lt * 16 + fq * 4);
      const float bs = BC[st * 16 + fr];
      const float blv[4] = {bl.x, bl.y, bl.z, bl.w};
#pragma unroll
      for (int j = 0; j < 4; ++j) {
        const int l = lt * 16 + fq * 4 + j, s2 = st * 16 + fr;
        PB[l * 40 + s2] = (u16)f2bf(s2 <= l ? acc[j] * __expf(blv[j] - bs) : 0.f);
      }
    } else {
#pragma unroll
      for (int j = 0; j < 4; ++j) PB[(fq * 4 + j) * 40 + 16 + fr] = 0;
    }
    __syncthreads();
    {
      const int lt = wave >> 1, vt = wave & 1;
      f32x4 acc = {0.f, 0.f, 0.f, 0.f};
#pragma unroll
      for (int ks = 0; ks < 4; ++ks)
        acc = MFMA16(lds8(CM + (lt * 16 + fr) * 136 + ks * 32 + fq * 8), lds8(ST + (vt * 16 + fr) * 136 + ks * 32 + fq * 8), acc);
      const float4 bl = *(const float4*)(BC + lt * 16 + fq * 4);
      acc[0] *= __expf(bl.x); acc[1] *= __expf(bl.y); acc[2] *= __expf(bl.z); acc[3] *= __expf(bl.w);
      bf16x8 v2f[2], bt8[2];
      const bf16x8 v1f = lds8(V1 + (vt * 16 + fr) * 40 + fq * 8);
      v2f[0] = lds8(V2 + fr * 40 + fq * 8);
      v2f[1] = lds8(V2 + (16 + fr) * 40 + fq * 8);
#pragma unroll
      for (int e = 0; e < 8; ++e) {
        bt8[0][e] = (short)BM[(fq * 8 + e) * 136 + (wave * 2) * 16 + fr];
        bt8[1][e] = (short)BM[(fq * 8 + e) * 136 + (wave * 2 + 1) * 16 + fr];
      }
      acc = MFMA16(lds8(PB + (lt * 16 + fr) * 40 + fq * 8), v1f, acc);
#pragma unroll
      for (int j = 0; j < 4; ++j) {
        const int row = scan_row(c * 32 + lt * 16 + fq * 4 + j, b, d);
        O[(size_t)row * D + colbase + vt * 16 + fr] = (u16)f2bf(acc[j]);
      }
#pragma unroll
      for (int a = 0; a < 2; ++a)
#pragma unroll
        for (int v2 = 0; v2 < 2; ++v2) {
          Sacc[a][v2][0] *= decS; Sacc[a][v2][1] *= decS; Sacc[a][v2][2] *= decS; Sacc[a][v2][3] *= decS;
          Sacc[a][v2] = MFMA16(bt8[a], v2f[v2], Sacc[a][v2]);
        }
    }
    __syncthreads();
#pragma unroll
    for (int a = 0; a < 2; ++a)
#pragma unroll
      for (int v2 = 0; v2 < 2; ++v2) {
        bf16x4 o;
#pragma unroll
        for (int j = 0; j < 4; ++j) o[j] = f2bf(Sacc[a][v2][j]);
        *(bf16x4*)(ST + (v2 * 16 + fr) * 136 + (wave * 2 + a) * 16 + fq * 4) = o;
      }
  }
  __syncthreads();
#undef SD_ISSUE
}

DEV void phase_xbc_conv(const Params& p, int nrows) {
  const u16* P = (const u16*)(p.ws + OFF_S + S_P);
  u16* F = (u16*)(p.ws + OFF_S + S_F);
  const int lane = threadIdx.x & 63;
  const int gw = blockIdx.x * 4 + (threadIdx.x >> 6), stride = gridDim.x * 4;
  const float* cw = p.in[I_CONVW];
  const float* cb = p.in[I_CONVB];
  for (int row = gw; row < nrows; row += stride) {
    const bool lat = row < MLAT;
    const int tpos = lat ? (row & 4095) : ((row - MLAT) & 255);
    const int T = lat ? 4096 : 256;
    const bool hm = tpos > 0, hp = tpos < T - 1;
    const float fm = hm ? 1.f : 0.f, fp = hp ? 1.f : 0.f;
    const int rm = hm ? row - 1 : row, rp = hp ? row + 1 : row;
#pragma unroll
    for (int hh = 0; hh < 2; ++hh) {
      const int c = lane * 16 + hh * 8;
      const bf16x8 xm = ld8(P, rm, 3072 + c), x0 = ld8(P, row, 3072 + c), xp = ld8(P, rp, 3072 + c);
      float w0[8], w1[8], w2[8], bb[8];
      *(float4*)(w0) = *(const float4*)(cw + c); *(float4*)(w0 + 4) = *(const float4*)(cw + c + 4);
      *(float4*)(w1) = *(const float4*)(cw + 1024 + c); *(float4*)(w1 + 4) = *(const float4*)(cw + 1024 + c + 4);
      *(float4*)(w2) = *(const float4*)(cw + 2048 + c); *(float4*)(w2 + 4) = *(const float4*)(cw + 2048 + c + 4);
      *(float4*)(bb) = *(const float4*)(cb + c); *(float4*)(bb + 4) = *(const float4*)(cb + c + 4);
      bf16x8 o;
#pragma unroll
      for (int e = 0; e < 8; ++e)
        o[e] = f2bf(silu(w0[e] * fm * bf2f(xm[e]) + w1[e] * bf2f(x0[e]) + w2[e] * fp * bf2f(xp[e]) + bb[e]));
      *(bf16x8*)(F + (size_t)row * D + c) = o;
    }
  }
}

DEV void phase_even_finish(const Params& p, int nrows) {
  const u16* P = (const u16*)(p.ws + OFF_S + S_P);
  u16* O0 = (u16*)(p.ws + OFF_S + S_H);
  const u16* O1 = (const u16*)(p.ws + OFF_S + S_O1);
  const int lane = threadIdx.x & 63;
  const int gw = blockIdx.x * 4 + (threadIdx.x >> 6), stride = gridDim.x * 4;
  const int c = lane * 8;
  for (int row = gw; row < nrows; row += stride) {
    {
      const bf16x8 a = *(const bf16x8*)(O0 + (size_t)row * D + c);
      const bf16x8 bq = *(const bf16x8*)(O1 + (size_t)row * D + c);
      const bf16x8 g = ld8(P, row, 2048 + c);
      float o[8], ss = 0.f;
#pragma unroll
      for (int e = 0; e < 8; ++e) { o[e] = bf2f(a[e]) + bf2f(bq[e]); ss += o[e] * o[e]; }
      ss = red16(ss);
      const float rstd = rsqrtf(ss * (1.0f / 128.0f) + 1e-6f);
      float hg[8];
      *(float4*)(hg) = *(const float4*)(p.in[I_HGRNG] + (c & 127)); *(float4*)(hg + 4) = *(const float4*)(p.in[I_HGRNG] + (c & 127) + 4);
      bf16x8 out;
#pragma unroll
      for (int e = 0; e < 8; ++e)
        out[e] = f2bf(o[e] * rstd * hg[e] * silu(bf2f(g[e])));
      *(bf16x8*)(O0 + (size_t)row * D + c) = out;
    }
    {
      const bf16x8 a = *(const bf16x8*)(O0 + (size_t)row * D + 512 + c);
      const bf16x8 bq = *(const bf16x8*)(O1 + (size_t)row * D + 512 + c);
      const bf16x8 z = ld8(P, row, 2560 + c);
      const bf16x8 xc = *(const bf16x8*)((const u16*)(p.ws + OFF_S + S_F) + (size_t)row * D + c);
      const float dsk = p.in[I_SSDD][c >> 6];
      float o[8], ss = 0.f;
#pragma unroll
      for (int e = 0; e < 8; ++e) {
        const float xs = bf2f(xc[e]);
        o[e] = (bf2f(a[e]) + bf2f(bq[e]) + dsk * xs) * silu(bf2f(z[e]));
        ss += o[e] * o[e];
      }
      ss = red16(ss);
      ss += __shfl_xor(ss, 16);
      const float rstd = rsqrtf(ss * (1.0f / 256.0f) + 1e-6f);
      float sg[8];
      *(float4*)(sg) = *(const float4*)(p.in[I_SSDG] + c); *(float4*)(sg + 4) = *(const float4*)(p.in[I_SSDG] + c + 4);
      bf16x8 out;
#pragma unroll
      for (int e = 0; e < 8; ++e) out[e] = f2bf(o[e] * rstd * sg[e]);
      *(bf16x8*)(O0 + (size_t)row * D + 512 + c) = out;
    }
  }
}

DEV void odd_scan_unit(const Params& p, int unit, char* smem) {
  float* wl = (float*)smem;
  float* kl = wl + 1024;
  float* al = kl + 1024;
  float* bl = al + 1024;
  float* rl = bl + 1024;
  float* at = rl + 1024;
  float* vl = at + 1024;
  const int tid = threadIdx.x, lane = tid & 63, wave = tid >> 6;
  const int fr = lane & 15, fq = lane >> 4;
  const int b = unit >> 6, head = (unit >> 2) & 15, d = (unit >> 1) & 1, rh = unit & 1;
  const char* S = p.ws + OFF_S;
  const u16* R = (const u16*)(S + S_R);
  const u16* Kb = (const u16*)(S + S_K);
  const u16* V = (const u16*)(S + S_V);
  const u16* LORA = (const u16*)(S + S_LORA);
  float* BON = (float*)(S + S_BON) + (size_t)d * MTOT * 16;
  u16* Y = (u16*)(S + (d ? S_Y1 : S_H));
  const u16* W2T = (const u16*)(p.ws + OFF_W + W_W2) + (size_t)d * D * 64;
  const u16* A2T = (const u16*)(p.ws + OFF_W + W_A2) + (size_t)d * D * 64;
  const int ncol = head * 64 + wave * 16 + fr;
  bf16x8 bw[2], ba[2];
#pragma unroll
  for (int ks = 0; ks < 2; ++ks) {
    bw[ks] = *(const bf16x8*)(W2T + (size_t)ncol * 64 + ks * 32 + fq * 8);
    ba[ks] = *(const bf16x8*)(A2T + (size_t)ncol * 64 + ks * 32 + fq * 8);
  }
  const float w0c = p.in[I_W0][d * D + ncol], a0c = p.in[I_A0][d * D + ncol];
  const int tok = tid >> 4, c4 = (tid & 15) * 4;
  float kkc[4], kac[4], rkc[4];
#pragma unroll
  for (int e = 0; e < 4; ++e) {
    kkc[e] = p.in[I_KK][head * 64 + c4 + e];
    kac[e] = p.in[I_KA][head * 64 + c4 + e];
    rkc[e] = p.in[I_RK][head * 64 + c4 + e];
  }
  const int jp = lane & 7, il = tid >> 3;
  float St[8];
#pragma unroll
  for (int j = 0; j < 8; ++j) St[j] = 0.f;

  bf16x8 fa0, fa1, fb0, fb1;
  bf16x4 kr, rr;
  bf16x2 vr;
#define OD_ISSUE(c)                                                                              \
  {                                                                                              \
    const int rowA = scan_row((c) * 16 + fr, b, d);                                              \
    fa0 = *(const bf16x8*)(LORA + (size_t)rowA * LLD + d * 64 + fq * 8);                         \
    fa1 = *(const bf16x8*)(LORA + (size_t)rowA * LLD + d * 64 + 32 + fq * 8);                    \
    fb0 = *(const bf16x8*)(LORA + (size_t)rowA * LLD + 128 + d * 64 + fq * 8);                   \
    fb1 = *(const bf16x8*)(LORA + (size_t)rowA * LLD + 128 + d * 64 + 32 + fq * 8);              \
    const int rowE = scan_row((c) * 16 + tok, b, d);                                             \
    kr = *(const bf16x4*)(Kb + (size_t)rowE * D + head * 64 + c4);                               \
    rr = *(const bf16x4*)(R + (size_t)rowE * D + head * 64 + c4);                                \
    vr = *(const bf16x2*)(V + (size_t)rowE * D + head * 64 + rh * 32 + (tid & 15) * 2);          \
  }
  OD_ISSUE(0);
  const int NCH = (256 + 4096) / 16;
  for (int c = 0; c < NCH; ++c) {
    f32x4 accw = {0.f, 0.f, 0.f, 0.f}, acca = {0.f, 0.f, 0.f, 0.f};
    accw = __builtin_amdgcn_mfma_f32_16x16x32_bf16(fa0, bw[0], accw, 0, 0, 0);
    accw = __builtin_amdgcn_mfma_f32_16x16x32_bf16(fa1, bw[1], accw, 0, 0, 0);
    acca = __builtin_amdgcn_mfma_f32_16x16x32_bf16(fb0, ba[0], acca, 0, 0, 0);
    acca = __builtin_amdgcn_mfma_f32_16x16x32_bf16(fb1, ba[1], acca, 0, 0, 0);
#pragma unroll
    for (int j = 0; j < 4; ++j) {
      const int t = fq * 4 + j, cc = wave * 16 + fr;
      const float zw = w0c + accw[j];
      wl[t * 64 + cc] = __expf(-0.6065306597126334f * sigm(zw));
      at[t * 64 + cc] = sigm(a0c + acca[j]);
    }
    __syncthreads();
    {
      const float4 a4 = *(const float4*)(at + tok * 64 + c4);
      const float av[4] = {a4.x, a4.y, a4.z, a4.w};
      float kku[4], kd[4], rv[4], ss = 0.f, bsum = 0.f;
#pragma unroll
      for (int e = 0; e < 4; ++e) {
        const float k = bf2f(kr[e]);
        rv[e] = bf2f(rr[e]);
        kku[e] = k * kkc[e];
        ss += kku[e] * kku[e];
        kd[e] = k * (1.0f + (av[e] - 1.0f) * kac[e]);
        bsum += rv[e] * kd[e] * rkc[e];
      }
      ss = red16(ss);
      bsum = red16(bsum);
      const float inv = rsqrtf(fmaxf(ss, 1e-24f));
      const int row = scan_row(c * 16 + tok, b, d);
      if ((tid & 15) == 0 && rh == 0) BON[(size_t)row * 16 + head] = bsum;
      float4 ko, ao, bo, ro;
      ko.x = kd[0]; ko.y = kd[1]; ko.z = kd[2]; ko.w = kd[3];
      ao.x = -kku[0] * inv; ao.y = -kku[1] * inv; ao.z = -kku[2] * inv; ao.w = -kku[3] * inv;
      bo.x = -ao.x * av[0]; bo.y = -ao.y * av[1]; bo.z = -ao.z * av[2]; bo.w = -ao.w * av[3];
      ro.x = rv[0]; ro.y = rv[1]; ro.z = rv[2]; ro.w = rv[3];
      *(float4*)(kl + tok * 64 + c4) = ko;
      *(float4*)(al + tok * 64 + c4) = ao;
      *(float4*)(bl + tok * 64 + c4) = bo;
      *(float4*)(rl + tok * 64 + c4) = ro;
      float2 vo; vo.x = bf2f(vr[0]); vo.y = bf2f(vr[1]);
      *(float2*)(vl + tok * 32 + (tid & 15) * 2) = vo;
    }
    __syncthreads();
    if (c + 1 < NCH) OD_ISSUE(c + 1);
    float yk0 = 0.f, yk1 = 0.f;
#pragma unroll 2
    for (int t = 0; t < 16; ++t) {
      const float4 w_a = *(const float4*)(wl + t * 64 + jp * 8), w_b = *(const float4*)(wl + t * 64 + jp * 8 + 4);
      const float4 k_a = *(const float4*)(kl + t * 64 + jp * 8), k_b = *(const float4*)(kl + t * 64 + jp * 8 + 4);
      const float4 a_a = *(const float4*)(al + t * 64 + jp * 8), a_b = *(const float4*)(al + t * 64 + jp * 8 + 4);
      const float4 b_a = *(const float4*)(bl + t * 64 + jp * 8), b_b = *(const float4*)(bl + t * 64 + jp * 8 + 4);
      const float4 r_a = *(const float4*)(rl + t * 64 + jp * 8), r_b = *(const float4*)(rl + t * 64 + jp * 8 + 4);
      const float vi = vl[t * 32 + il];
      const float ww[8] = {w_a.x, w_a.y, w_a.z, w_a.w, w_b.x, w_b.y, w_b.z, w_b.w};
      const float kk[8] = {k_a.x, k_a.y, k_a.z, k_a.w, k_b.x, k_b.y, k_b.z, k_b.w};
      const float aa[8] = {a_a.x, a_a.y, a_a.z, a_a.w, a_b.x, a_b.y, a_b.z, a_b.w};
      const float bb[8] = {b_a.x, b_a.y, b_a.z, b_a.w, b_b.x, b_b.y, b_b.z, b_b.w};
      const float rq[8] = {r_a.x, r_a.y, r_a.z, r_a.w, r_b.x, r_b.y, r_b.z, r_b.w};
      float sa = 0.f;
#pragma unroll
      for (int j = 0; j < 8; ++j) sa += St[j] * aa[j];
      sa = red8(sa);
      float y = 0.f;
#pragma unroll
      for (int j = 0; j < 8; ++j) {
        St[j] = St[j] * ww[j] + sa * bb[j] + vi * kk[j];
        y += St[j] * rq[j];
      }
      y = red8(y);
      yk0 = (jp == t) ? y : yk0;
      yk1 = (jp + 8 == t) ? y : yk1;
    }
    {
      const int row0 = scan_row(c * 16 + jp, b, d), row1 = scan_row(c * 16 + 8 + jp, b, d);
      Y[(size_t)row0 * D + head * 64 + rh * 32 + il] = (u16)f2bf(yk0);
      Y[(size_t)row1 * D + head * 64 + rh * 32 + il] = (u16)f2bf(yk1);
    }
    __syncthreads();
  }
}

DEV void phase_odd_finish(const Params& p, int nrows) {
  const char* S = p.ws + OFF_S;
  u16* Y0 = (u16*)(p.ws + OFF_S + S_H);
  const u16* Y1 = (const u16*)(S + S_Y1);
  const u16* V = (const u16*)(S + S_V);
  const u16* Gb = (const u16*)(S + S_G);
  const float* BON = (const float*)(S + S_BON);
  const int lane = threadIdx.x & 63;
  const int gw = blockIdx.x * 4 + (threadIdx.x >> 6), stride = gridDim.x * 4;
  const int c = lane * 16, head = lane >> 2;
  for (int row = gw; row < nrows; row += stride) {
    float y[16], sum = 0.f;
#pragma unroll
    for (int hh = 0; hh < 2; ++hh) {
      const bf16x8 a = *(const bf16x8*)(Y0 + (size_t)row * D + c + hh * 8);
      const bf16x8 bq = *(const bf16x8*)(Y1 + (size_t)row * D + c + hh * 8);
#pragma unroll
      for (int e = 0; e < 8; ++e) { y[hh * 8 + e] = bf2f(a[e]) + bf2f(bq[e]); sum += y[hh * 8 + e]; }
    }
    sum = red4(sum);
    const float mu = sum * (1.0f / 64.0f);
    float var = 0.f;
#pragma unroll
    for (int e = 0; e < 16; ++e) { const float dlt = y[e] - mu; var += dlt * dlt; }
    var = red4(var) * (1.0f / 64.0f);
    const float rstd = rsqrtf(var + 64e-5f);
    const float bon = BON[(size_t)row * 16 + head] + BON[(size_t)MTOT * 16 + (size_t)row * 16 + head];
#pragma unroll
    for (int hh = 0; hh < 2; ++hh) {
      const bf16x8 v = *(const bf16x8*)(V + (size_t)row * D + c + hh * 8);
      const bf16x8 g = *(const bf16x8*)(Gb + (size_t)row * D + c + hh * 8);
      float lw[8], lbv[8];
      *(float4*)(lw) = *(const float4*)(p.in[I_LNW] + c + hh * 8); *(float4*)(lw + 4) = *(const float4*)(p.in[I_LNW] + c + hh * 8 + 4);
      *(float4*)(lbv) = *(const float4*)(p.in[I_LNB] + c + hh * 8); *(float4*)(lbv + 4) = *(const float4*)(p.in[I_LNB] + c + hh * 8 + 4);
      bf16x8 out;
#pragma unroll
      for (int e = 0; e < 8; ++e) {
        const float yn = (y[hh * 8 + e] - mu) * rstd * lw[e] + lbv[e];
        out[e] = f2bf((yn + bon * bf2f(v[e])) * bf2f(g[e]));
      }
      *(bf16x8*)(Y0 + (size_t)row * D + c + hh * 8) = out;
    }
  }
}

constexpr int NPHASE = 30;

DEV void run_phase(const Params& p, int ph, char* smem) {
  char* S = p.ws + OFF_S;
  char* W = p.ws + OFF_W;
  float* X = (float*)(p.ws + OFF_X);
  const float* MOD = (const float*)(p.ws + OFF_MOD);
  u16* H = (u16*)(S + S_H);
  if (ph == 0) { phase_prep(p, 0, smem); return; }
  if (ph == 13) { phase_prep(p, 1, smem); return; }
  if (ph == 29) { phase_final(p); return; }
  const int layer = ph >= 14 ? 1 : 0;
  int q = layer ? ph - 14 : ph - 1;
  if (layer == 0 && q == 5) { phase_xbc_conv(p, MTOT); return; }
  if (layer == 0 && q > 5) q -= 1;
  if (layer == 1 && q >= 4 && q <= 7) {
    u16* XA0 = (u16*)(S + S_Y1);
    u16* XA1 = (u16*)(S + S_G);
    if (q == 4) { phase_mix(p, 0, XA0, 2, XA1, MTOT); return; }
    if (q == 5) {
      gemm_tiles(smem, (const u16*)(W + W_R), D, D, MTOT / 128, 16, 0, ATwo{XA0, XA1},
                 EpOdd{(u16*)(S + S_R), (u16*)(S + S_LORA)});
      return;
    }
    if (q == 6) { phase_mix(p, 3, XA0, 0, nullptr, MTOT); return; }
    gemm_tiles<AShift, EpLora, false>(smem, (const u16*)(W + W_W1), D, D, MTOT / 128, 3, 0, AShift{H, p.in[I_XMIX], 24},
               EpLora{(u16*)(S + S_LORA)});
    gemm_tiles(smem, (const u16*)(W + W_V), D, D, MTOT / 128, 8, 51, APlain{XA0, D}, EpStore{(u16*)(S + S_V), D, D, 0, 0});
    return;
  }
  if (layer == 1 && q > 7) q -= 3;
  const float* modl = MOD + (size_t)layer * 5 * 9216;
  const float* ng = p.in[I_NORMG] + (size_t)layer * 3 * D;
  const bool first = (layer == 0);
  const float* xin_lat = X; const float* xin_ctx = X + (size_t)MLAT * D;
  if (q == 0) {
    if (first) phase_norm(p, p.in[I_X], p.in[I_CTX], ng, modl, 0, MTOT);
    else phase_norm(p, xin_lat, xin_ctx, ng, modl, 0, MTOT, 0, 8, 0.5f, xin_lat, xin_ctx, MOD);

    return;
  }
  if (q == 1) {
    gemm256(smem, (const u16*)(W + W_WI0), D, D, MTOT / 256, 44, APlain{H, D}, EpSwiglu{(u16*)(S + S_ACT)});
    return;
  }
  if (q == 2) {
    if (first)
      gemm_tiles<APlain, EpResid, true, false>(smem, (const u16*)(W + W_WO0), FF, FF, MTOT / 128, 8, 0, APlain{(const u16*)(S + S_ACT), FF},
                 EpResid{p.in[I_X], p.in[I_CTX], X, modl, 2, 0.5f}, (float*)(S + S_PART));
    else
      gemm_tiles<APlain, EpResid, true, false>(smem, (const u16*)(W + W_WO0), FF, FF, MTOT / 128, 8, 0, APlain{(const u16*)(S + S_ACT), FF},
                 EpResid{xin_lat, xin_ctx, X, modl, 2, 0.5f}, (float*)(S + S_PART));
    return;
  }
  if (q == 3) {
    if (first) phase_norm(p, xin_lat, xin_ctx, ng + D, modl, 1, MTOT, 0, 2, 0.5f, p.in[I_X], p.in[I_CTX], modl);
    else phase_norm(p, xin_lat, xin_ctx, ng + D, modl, 1, MTOT, 0, 2, 0.5f, xin_lat, xin_ctx, modl);
    return;
  }
  if (layer == 0) {
    if (q == 4) {
      gemm_tiles(smem, (const u16*)(W + W_IN), D, D, MTOT / 128, 33, 0, APlain{H, D},
                 EpEvenIn{(u16*)(S + S_P), (const float*)(p.ws + OFF_LBT)});
      return;
    }
    if (q == 5) {
      for (int u = blockIdx.x; u < 256; u += gridDim.x) {
        if (u < 128) hgrn_chunk_unit(p, u, smem);
        else ssd_chunk_unit(p, u - 128, smem);
      }
      return;
    }
    if (q == 6) { phase_even_finish(p, MTOT); return; }
    if (q == 7) {
      gemm_tiles<APlain, EpResid, true, false>(smem, (const u16*)(W + W_OUT), D, D, MTOT / 128, 8, 0, APlain{H, D},
                 EpResid{xin_lat, xin_ctx, X, modl, 5, 1.0f}, (float*)(S + S_PART));
      return;
    }
    if (q == 8) { phase_norm(p, xin_lat, xin_ctx, ng + 2 * D, modl, 2, MTOT, 0, 5, 1.0f, xin_lat, xin_ctx, modl); return; }
    if (q == 9) {
      gemm256(smem, (const u16*)(W + W_WI1), D, D, MTOT / 256, 44, APlain{H, D}, EpSwiglu{(u16*)(S + S_ACT)});
      return;
    }
    if (q == 10) {
      gemm_tiles<APlain, EpResid, true, false>(smem, (const u16*)(W + W_WO1), FF, FF, MTOT / 128, 8, 0, APlain{(const u16*)(S + S_ACT), FF},
                 EpResid{xin_lat, xin_ctx, X, modl, 8, 0.5f}, (float*)(S + S_PART));
      return;
    }
  } else {
    if (q == 4) {
      gemm_tiles<AShift, EpOdd, false>(smem, (const u16*)(W + W_R), D, D, MTOT / 128, 27, 0, AShift{H, p.in[I_XMIX], 0},
                 EpOdd{(u16*)(S + S_R), (u16*)(S + S_LORA)});
      return;
    }
    if (q == 5) {
      for (int u = blockIdx.x; u < 256; u += gridDim.x) odd_scan_unit(p, u, smem);
      return;
    }
    if (q == 6) {
      gemm_tiles(smem, (const u16*)(W + W_G2), 128, 128, MLAT / 128, 8, 0, APlain{(const u16*)(S + S_LORA) + 256, LLD},
                 EpStore{(u16*)(S + S_G), D, D, 0, 0});
      return;
    }
    if (q == 7) { phase_odd_finish(p, MLAT); return; }
    if (q == 8) {
      gemm256(smem, (const u16*)(W + W_O), D, D, MLAT / 256, 8, APlain{H, D},
              EpResid{xin_lat, xin_ctx, X, modl, 5, 1.0f});
      return;
    }
    if (q == 9) { phase_norm(p, xin_lat, xin_ctx, ng + 2 * D, modl, 2, MLAT); return; }
    if (q == 10) {
      gemm256(smem, (const u16*)(W + W_WI1), D, D, MLAT / 256, 44, APlain{H, D}, EpSwiglu{(u16*)(S + S_ACT)});
      return;
    }
    if (q == 11) {
      gemm256(smem, (const u16*)(W + W_WO1), FF, FF, MLAT / 256, 8, APlain{(const u16*)(S + S_ACT), FF},
              EpResid{xin_lat, xin_ctx, X, modl, 8, 0.5f});
      return;
    }
  }
}

__global__ void __launch_bounds__(256, 2) mega_kernel(Params p, int ph_lo, int ph_hi) {
  __shared__ __attribute__((aligned(16))) char smem[65536];
  cg::grid_group grid = cg::this_grid();
  XcdBarrier gb = xcd_barrier_post((unsigned*)(p.ws + OFF_BAR));
  if (ph_hi > 1000) grid.sync();
#ifdef PH_ONLY
  run_phase(p, PH_ONLY, smem);
  if (ph_lo < 0) grid.sync();
#else
#ifndef PROBE_DUP
#define PROBE_DUP -1
#endif
#define PHASE(k) if (ph_lo <= (k) && (k) < ph_hi) { run_phase(p, (k), smem); if ((k) == PROBE_DUP) { __syncthreads(); run_phase(p, (k), smem); } if ((k) + 1 < ph_hi) xcd_barrier(gb); }
  PHASE(0) PHASE(1) PHASE(2) PHASE(3) PHASE(4) PHASE(5) PHASE(6) PHASE(7) PHASE(8) PHASE(9) PHASE(10) PHASE(11) PHASE(12)
  PHASE(13) PHASE(14) PHASE(15) PHASE(16) PHASE(17) PHASE(18) PHASE(19) PHASE(20) PHASE(21) PHASE(22) PHASE(23) PHASE(24) PHASE(25) PHASE(26) PHASE(27) PHASE(28) PHASE(29)
#endif
}

#ifndef N_SPLIT
#define N_SPLIT 0
#endif

extern "C" void kernel_launch(void* const* d_in, const int* in_sizes, int n_in, void* d_out, int out_size, void* d_ws,
                              size_t ws_size, hipStream_t stream) {
  static int grid_blocks = 0;
  if (!grid_blocks) {
    int dev = 0, cus = 0, per_cu = 0;
    hipGetDevice(&dev);
    hipDeviceGetAttribute(&cus, hipDeviceAttributeMultiprocessorCount, dev);
    hipOccupancyMaxActiveBlocksPerMultiprocessor(&per_cu, mega_kernel, 256, 0);
    if (per_cu > 2) per_cu = 2;
    if (per_cu < 1) per_cu = 1;
    grid_blocks = cus * per_cu;
  }
  Params p{};
  for (int i = 0; i < 38; ++i) p.in[i] = (const float*)d_in[i];
  p.out = (float*)d_out;
  p.ws = (char*)d_ws;
#if N_SPLIT
  for (int ph = 0; ph < NPHASE; ++ph) {
    int lo = ph, hi = ph + 1;
    void* args[] = {&p, &lo, &hi};
    hipError_t e = hipLaunchCooperativeKernel((void*)mega_kernel, dim3(grid_blocks), dim3(256), args, 0, stream);
    if (e != hipSuccess) fprintf(stderr, "cooperative launch failed: %s (grid %d)\n", hipGetErrorString(e), grid_blocks);
  }
#else
  hipMemsetAsync((char*)d_ws + OFF_BAR, 0, XCD_BAR_WORDS * 4, stream);
  int lo = 0, hi = NPHASE;
  void* args[] = {&p, &lo, &hi};
  hipError_t e = hipLaunchCooperativeKernel((void*)mega_kernel, dim3(grid_blocks), dim3(256), args, 0, stream);
  if (e != hipSuccess) fprintf(stderr, "cooperative launch failed: %s (grid %d)\n", hipGetErrorString(e), grid_blocks);
#endif
}
```

```cpp
#include <hip/hip_runtime.h>
#include <hip/hip_cooperative_groups.h>
#include <cstdio>
namespace cg = cooperative_groups;

#define DEV __device__ __forceinline__
typedef unsigned short u16;
typedef __attribute__((ext_vector_type(8))) short bf16x8;
typedef __attribute__((ext_vector_type(4))) short bf16x4;
typedef __attribute__((ext_vector_type(2))) short bf16x2;
typedef __attribute__((ext_vector_type(4))) float f32x4;

constexpr int D = 1024;
constexpr int MLAT = 16384;
constexpr int MCTX = 1024;
constexpr int MTOT = 17408;
constexpr int FF = 2816;
constexpr int PLD = 4112;
constexpr int LLD = 384;

constexpr size_t OFF_X = 0;
constexpr size_t OFF_MOD = 71303168;
constexpr size_t OFF_W = OFF_MOD + 368640;
constexpr size_t W_WI0 = 0, W_WI1 = 11534336, W_WO0 = 23068672, W_WO1 = 28835840, W_MIX = 34603008;
constexpr size_t W_IN = W_MIX, W_OUT = W_MIX + 8650752;
constexpr size_t W_R = W_MIX, W_K = W_MIX + 2097152, W_V = W_MIX + 4194304;
constexpr size_t W_W1 = W_MIX + 6291456, W_A1 = W_W1 + 262144, W_G1 = W_A1 + 262144;
constexpr size_t W_O = W_G1 + 262144;
constexpr size_t W_W2 = W_O + 2097152, W_A2 = W_W2 + 262144, W_G2 = W_A2 + 262144;
constexpr size_t WSIZE = 46000128;
constexpr size_t OFF_S = OFF_W + WSIZE;
constexpr size_t SZ_H = 35651584;
constexpr size_t S_H = 0;
constexpr size_t S_ACT = SZ_H;
constexpr size_t S_O1 = SZ_H, S_P = 2 * SZ_H;
constexpr size_t S_Y1 = SZ_H, S_R = 2 * SZ_H, S_K = 3 * SZ_H, S_V = 4 * SZ_H, S_G = 5 * SZ_H;
constexpr size_t S_LORA = 6 * SZ_H;
constexpr size_t S_BON = S_LORA + 13369344;
constexpr size_t OFF_BAR = OFF_W + 45400064;
constexpr size_t OFF_LBT = OFF_BAR + 16384;
constexpr size_t S_PART = 4 * SZ_H;
constexpr size_t S_F = 2 * SZ_H + 143163392;

struct Params {
  const float* in[38];
  float* out;
  char* ws;
};

enum { I_X = 0, I_C, I_CTX, I_CCTX, I_ADAW, I_ADAB, I_NORMG, I_WI, I_WO, I_FINALG, I_LB, I_EVIN, I_EVOUT,
       I_HGRNG, I_CONVW, I_CONVB, I_DTB, I_ALOG, I_SSDD, I_SSDG, I_XMIX, I_WR, I_WK, I_WV, I_WOO, I_W0, I_W1,
       I_W2, I_A0, I_A1, I_A2, I_G1, I_G2, I_KK, I_KA, I_RK, I_LNW, I_LNB };

DEV float bf2f(short v) { return __uint_as_float(((unsigned)(unsigned short)v) << 16); }
DEV short f2bf(float f) { return __builtin_bit_cast(short, (__bf16)f); }
DEV float sigm(float x) { return __builtin_amdgcn_rcpf(1.0f + __expf(-x)); }
DEV float silu(float x) { return x * sigm(x); }

template <int CTRL>
DEV float dppf(float v) {
  return __int_as_float(__builtin_amdgcn_update_dpp(0, __float_as_int(v), CTRL, 0xF, 0xF, true));
}
DEV float red4(float v) { v += dppf<0xB1>(v); v += dppf<0x4E>(v); return v; }
DEV float red8(float v) { v = red4(v); v += dppf<0x141>(v); return v; }
DEV float red16(float v) { v = red8(v); v += dppf<0x140>(v); return v; }
DEV float red64(float v) {
  v = red16(v);
  v += __shfl_xor(v, 16);
  v += __shfl_xor(v, 32);
  return v;
}


#define XB_TMO      128
#define XB_XCNT(j)  (256  + 64 * (j))
#define XB_XSUB(j)  (1280 + 64 * (j))
#define XB_XGEN(j)  (2304 + 64 * (j))
#define XB_TOP      3328
#define XB_TOPGEN   3392
#define XCD_BAR_WORDS 3456
#define XB_SPIN_CAP (1u << 20)
DEV unsigned xb_ld(unsigned* p) { return __hip_atomic_load(p, __ATOMIC_RELAXED, __HIP_MEMORY_SCOPE_AGENT); }
DEV unsigned xb_add(unsigned* p, unsigned v) { return __hip_atomic_fetch_add(p, v, __ATOMIC_RELAXED, __HIP_MEMORY_SCOPE_AGENT); }
DEV unsigned xb_xcc_id() { return (unsigned)__builtin_amdgcn_s_getreg((3 << 11) | 20) & 0xFu; }
#define XB_SPIN(cond, bar) do { unsigned _sp = 0; while (cond) { __builtin_amdgcn_s_sleep(1); \
    if ((++_sp & 255u) == 0u) { if (xb_ld(&(bar)[XB_TMO])) break; if (_sp > XB_SPIN_CAP) { atomicAdd(&(bar)[XB_TMO], 1u); break; } } } } while (0)
struct XcdBarrier { unsigned* bar; unsigned x; unsigned nloc; unsigned nx; };
DEV XcdBarrier xcd_barrier_post(unsigned* bar) {
  XcdBarrier b; b.bar = bar; b.x = xb_xcc_id(); b.nloc = 0u; b.nx = 0u;
  if (threadIdx.x == 0) (void)xb_add(&bar[XB_XCNT(b.x)], 1u);
  return b;
}
DEV void xcd_barrier_complete(unsigned* bar, unsigned x, unsigned& nloc, unsigned& nx) {
  const unsigned G = gridDim.x;
  unsigned sum, cnt, mine, sp = 0u;
  for (;;) {
    sum = 0u; cnt = 0u; mine = 0u;
#pragma unroll
    for (unsigned j = 0; j < 16; ++j) { const unsigned c = xb_ld(&bar[XB_XCNT(j)]); sum += c; cnt += (c > 0u) ? 1u : 0u; mine = (j == x) ? c : mine; }
    if (sum == G) break;
    __builtin_amdgcn_s_sleep(1);
    if ((++sp & 255u) == 0u) { if (xb_ld(&bar[XB_TMO])) break; if (sp > XB_SPIN_CAP) { atomicAdd(&bar[XB_TMO], 1u); break; } }
  }
  nloc = mine > 0u ? mine : 1u; nx = cnt > 0u ? cnt : 1u;
}
DEV void xcd_barrier(XcdBarrier& b) {
  asm volatile("s_waitcnt vmcnt(0)" ::: "memory");
  __syncthreads();
  if (threadIdx.x == 0) {
    unsigned* bar = b.bar;
    __builtin_amdgcn_s_waitcnt(0);
    if (b.nloc == 0u) xcd_barrier_complete(bar, b.x, b.nloc, b.nx);
    const unsigned nloc = b.nloc, nx = b.nx;
    const unsigned old = xb_add(&bar[XB_XSUB(b.x)], 1u);
    const unsigned gen = old / nloc;
    if (old + 1u == (gen + 1u) * nloc) {
      __builtin_amdgcn_fence(__ATOMIC_RELEASE, "agent");
      asm volatile("s_waitcnt vmcnt(0)" ::: "memory");
      const unsigned og = xb_add(&bar[XB_TOP], 1u);
      const unsigned tg = og / nx;
      if (og + 1u == (tg + 1u) * nx) xb_add(&bar[XB_TOPGEN], 1u);
      else XB_SPIN(xb_ld(&bar[XB_TOPGEN]) == tg, bar);
      __builtin_amdgcn_fence(__ATOMIC_ACQUIRE, "agent");
      xb_add(&bar[XB_XGEN(b.x)], 1u);
      asm volatile("s_waitcnt vmcnt(0)" ::: "memory");
    } else {
      XB_SPIN(xb_ld(&bar[XB_XGEN(b.x)]) == gen, bar);
      __builtin_amdgcn_fence(__ATOMIC_ACQUIRE, "agent");
      asm volatile("s_waitcnt vmcnt(0)" ::: "memory");
    }
  }
  __syncthreads();
}

DEV const float* xrow_ptr(const float* lat, const float* ctx, int row) {
  return row < MLAT ? lat + (size_t)row * D : ctx + (size_t)(row - MLAT) * D;
}
DEV int mod_idx(int row) { return row < MLAT ? (row >> 12) : 4; }

struct APlain {
  const u16* A; int lda;
  DEV bf16x8 operator()(int row, int k, int tn) const { return *(const bf16x8*)(A + (size_t)row * lda + k); }
};

struct AShift {
  const u16* H; const float* mixbase; int tn_off;
  DEV bf16x8 operator()(int row, int k, int tn0) const {
    const int tn = tn0 + tn_off;
    const int jsel = tn < 24 ? (tn < 8 ? 0 : (tn < 16 ? 2 : 3)) : (tn == 24 ? 1 : (tn == 25 ? 4 : 5));
    const float* mix = mixbase + jsel * D;
    bf16x8 own = *(const bf16x8*)(H + (size_t)row * D + k);
    const int q = k >> 8;
    int nrow; bool valid;
    if (row < MLAT) {
      const int t = row & 4095, cx = t & 63, ry = t >> 6;
      if (q == 0) { valid = cx > 0; nrow = row - 1; }
      else if (q == 1) { valid = cx < 63; nrow = row + 1; }
      else if (q == 2) { valid = ry > 0; nrow = row - 64; }
      else { valid = ry < 63; nrow = row + 64; }
    } else {
      const int t = (row - MLAT) & 255;
      if ((q & 1) == 0) { valid = t > 0; nrow = row - 1; }
      else { valid = t < 255; nrow = row + 1; }
    }
    bf16x8 nb = *(const bf16x8*)(H + (size_t)(valid ? nrow : row) * D + k);
    if (!valid) nb = bf16x8{0, 0, 0, 0, 0, 0, 0, 0};
    const float4 m0 = *(const float4*)(mix + k), m1 = *(const float4*)(mix + k + 4);
    const float mm[8] = {m0.x, m0.y, m0.z, m0.w, m1.x, m1.y, m1.z, m1.w};
    bf16x8 o;
#pragma unroll
    for (int e = 0; e < 8; ++e) {
      const float a = bf2f(own[e]), sft = bf2f(nb[e]);
      o[e] = f2bf(a + (sft - a) * mm[e]);
    }
    return o;
  }
};

DEV float act_apply(float v, int act) {
  if (act == 1) return 2.0f * sigm(2.0f * v) - 1.0f;
  if (act == 2) return sigm(v);
  return v;
}
DEV void store16_bf16(u16* dst, const f32x4 (&a)[4], int act) {
  bf16x8 o0, o1;
#pragma unroll
  for (int j = 0; j < 4; ++j) {
    o0[j] = f2bf(act_apply(a[0][j], act)); o0[4 + j] = f2bf(act_apply(a[1][j], act));
    o1[j] = f2bf(act_apply(a[2][j], act)); o1[4 + j] = f2bf(act_apply(a[3][j], act));
  }
  *(bf16x8*)dst = o0;
  *(bf16x8*)(dst + 8) = o1;
}

struct EpStore {
  u16* C; int ldc; int ncols; int act; int coloff;
  DEV void operator()(f32x4 (&acc)[4][4], int rbase, int cbase, int lane) const {
    const int fr = lane & 15, fq = lane >> 4;
    const int col = cbase + fq * 16;
    if (col < ncols) {
#pragma unroll
      for (int m = 0; m < 4; ++m) {
        const int row = rbase + m * 16 + fr;
        store16_bf16(C + (size_t)row * ldc + coloff + col, acc[m], act);
      }
    }
  }
};

struct EpEvenIn {
  u16* P; const float* lbt;
  DEV void operator()(f32x4 (&acc)[4][4], int rbase, int cbase, int lane) const {
    const int fr = lane & 15, fq = lane >> 4;
    const int col = cbase + fq * 16;
    if (col >= PLD) return;
    const int mode = col < 512 ? 1 : ((col >= 1024 && col < 2048) ? 2 : 0);
    float oml[16];
    if (mode == 2) {
#pragma unroll
      for (int n = 0; n < 4; ++n) {
        const float4 l4 = *(const float4*)(lbt + (col - 1024) + n * 4);
        oml[n * 4 + 0] = 1.0f - l4.x; oml[n * 4 + 1] = 1.0f - l4.y; oml[n * 4 + 2] = 1.0f - l4.z; oml[n * 4 + 3] = 1.0f - l4.w;
      }
    } else {
#pragma unroll
      for (int e = 0; e < 16; ++e) oml[e] = 0.f;
    }
#pragma unroll
    for (int m = 0; m < 4; ++m) {
      const int row = rbase + m * 16 + fr;
      bf16x8 o0, o1;
#pragma unroll
      for (int n = 0; n < 4; ++n)
#pragma unroll
        for (int j = 0; j < 4; ++j) {
          float v = acc[m][n][j];
          if (mode == 1) v = silu(v);
          else if (mode == 2) v = oml[n * 4 + j] * sigm(-v);
          const short h = f2bf(v);
          if (n < 2) o0[n * 4 + j] = h; else o1[(n - 2) * 4 + j] = h;
        }
      *(bf16x8*)(P + (size_t)row * PLD + col) = o0;
      *(bf16x8*)(P + (size_t)row * PLD + col + 8) = o1;
    }
  }
};

struct EpOdd {
  u16* RKV; u16* LORA;
  DEV void operator()(f32x4 (&acc)[4][4], int rbase, int cbase, int lane) const {
    const int fr = lane & 15, fq = lane >> 4;
    const int tn = cbase >> 7;
    if (tn < 24) {
      u16* C = RKV + (size_t)(tn >> 3) * (SZ_H / 2);
      const int col = (cbase & 1023) + fq * 16;
#pragma unroll
      for (int m = 0; m < 4; ++m) store16_bf16(C + (size_t)(rbase + m * 16 + fr) * D + col, acc[m], 0);
    } else {
      const int act = tn == 24 ? 1 : (tn == 25 ? 0 : 2);
      const int col = (tn - 24) * 128 + (cbase & 127) + fq * 16;
#pragma unroll
      for (int m = 0; m < 4; ++m) store16_bf16(LORA + (size_t)(rbase + m * 16 + fr) * LLD + col, acc[m], act);
    }
  }
};

struct EpSwiglu {
  u16* ACT;
  DEV void operator()(f32x4 (&acc)[4][4], int rbase, int cbase, int lane) const {
    const int fr = lane & 15, fq = lane >> 4;
    const int col = (cbase >> 1) + fq * 8;
#pragma unroll
    for (int m = 0; m < 4; ++m) {
      const int row = rbase + m * 16 + fr;
      bf16x8 o;
#pragma unroll
      for (int nn = 0; nn < 2; ++nn)
#pragma unroll
        for (int j = 0; j < 4; ++j) o[nn * 4 + j] = f2bf(silu(acc[m][nn][j]) * acc[m][nn + 2][j]);
      *(bf16x8*)(ACT + (size_t)row * FF + col) = o;
    }
  }
};

struct EpResid {
  const float* xlat; const float* xctx; float* xout; const float* modl; int gidx; float scale;
  DEV void operator()(f32x4 (&acc)[4][4], int rbase, int cbase, int lane) const {
    const int fr = lane & 15, fq = lane >> 4;
    const int col = cbase + fq * 16;
    const float* gate = modl + (size_t)mod_idx(rbase) * 9216 + gidx * 1024 + col;
    float4 gv[4];
#pragma unroll
    for (int n = 0; n < 4; ++n) {
      gv[n] = *(const float4*)(gate + n * 4);
      gv[n].x *= scale; gv[n].y *= scale; gv[n].z *= scale; gv[n].w *= scale;
    }
#pragma unroll
    for (int m = 0; m < 4; ++m) {
      const int row = rbase + m * 16 + fr;
      const float* xi = xrow_ptr(xlat, xctx, row) + col;
      float* xo = xout + (size_t)row * D + col;
#pragma unroll
      for (int n = 0; n < 4; ++n) {
        float4 v = *(const float4*)(xi + n * 4);
        v.x += gv[n].x * acc[m][n][0]; v.y += gv[n].y * acc[m][n][1];
        v.z += gv[n].z * acc[m][n][2]; v.w += gv[n].w * acc[m][n][3];
        *(float4*)(xo + n * 4) = v;
      }
    }
  }
};

struct ATwo {
  const u16* A0; const u16* A1;
  DEV bf16x8 operator()(int row, int k, int tn) const { return *(const bf16x8*)((tn < 8 ? A0 : A1) + (size_t)row * D + k); }
};

struct EpLora {
  u16* LORA;
  DEV void operator()(f32x4 (&acc)[4][4], int rbase, int cbase, int lane) const {
    const int fr = lane & 15, fq = lane >> 4;
    const int tn = cbase >> 7;
    const int act = tn == 0 ? 1 : (tn == 1 ? 0 : 2);
    const int col = cbase + fq * 16;
#pragma unroll
    for (int m = 0; m < 4; ++m) store16_bf16(LORA + (size_t)(rbase + m * 16 + fr) * LLD + col, acc[m], act);
  }
};

DEV void phase_mix(const Params& p, int j0, u16* dst0, int j1, u16* dst1, int nrows) {
  const u16* H = (const u16*)(p.ws + OFF_S + S_H);
  const int lane = threadIdx.x & 63;
  const int gw = blockIdx.x * 4 + (threadIdx.x >> 6), stride = gridDim.x * 4;
  const int q = lane >> 4;
  for (int row = gw; row < nrows; row += stride) {
    int nrow; bool valid;
    if (row < MLAT) {
      const int t = row & 4095, cx = t & 63, ry = t >> 6;
      if (q == 0) { valid = cx > 0; nrow = row - 1; }
      else if (q == 1) { valid = cx < 63; nrow = row + 1; }
      else if (q == 2) { valid = ry > 0; nrow = row - 64; }
      else { valid = ry < 63; nrow = row + 64; }
    } else {
      const int t = (row - MLAT) & 255;
      if ((q & 1) == 0) { valid = t > 0; nrow = row - 1; }
      else { valid = t < 255; nrow = row + 1; }
    }
#pragma unroll
    for (int hh = 0; hh < 2; ++hh) {
      const int c = lane * 16 + hh * 8;
      const bf16x8 own = *(const bf16x8*)(H + (size_t)row * D + c);
      bf16x8 nb = *(const bf16x8*)(H + (size_t)(valid ? nrow : row) * D + c);
      if (!valid) nb = bf16x8{0, 0, 0, 0, 0, 0, 0, 0};
      float m0[8], m1[8];
      *(float4*)(m0) = *(const float4*)(p.in[I_XMIX] + j0 * D + c); *(float4*)(m0 + 4) = *(const float4*)(p.in[I_XMIX] + j0 * D + c + 4);
      bf16x8 o0, o1;
#pragma unroll
      for (int e = 0; e < 8; ++e) {
        const float a = bf2f(own[e]), sft = bf2f(nb[e]);
        o0[e] = f2bf(a + (sft - a) * m0[e]);
      }
      *(bf16x8*)(dst0 + (size_t)row * D + c) = o0;
      if (dst1) {
        *(float4*)(m1) = *(const float4*)(p.in[I_XMIX] + j1 * D + c); *(float4*)(m1 + 4) = *(const float4*)(p.in[I_XMIX] + j1 * D + c + 4);
#pragma unroll
        for (int e = 0; e < 8; ++e) {
          const float a = bf2f(own[e]), sft = bf2f(nb[e]);
          o1[e] = f2bf(a + (sft - a) * m1[e]);
        }
        *(bf16x8*)(dst1 + (size_t)row * D + c) = o1;
      }
    }
  }
}

DEV int keyB(int r) { return (((r >> 4) & 3) << 1) | ((r >> 1) & 1); }

#ifndef GM
#define GM 8
#endif
template <class AL, bool DEEP>
DEV void gemm_kloop(char* smem, const u16* __restrict__ Bt, int ldb, const AL& al, int row0, int col0, int tn,
                    int kt_lo, int nk, f32x4 (&acc)[4][4]) {
  const int tid = threadIdx.x, lane = tid & 63, wave = tid >> 6;
  const int wm = wave >> 1, wn = wave & 1, fr = lane & 15, fq = lane >> 4;
  const int r0 = tid >> 3, c0 = tid & 7;
  const int kB = ((fr >> 2) << 1) | ((fr >> 1) & 1);
#pragma unroll
  for (int m = 0; m < 4; ++m)
#pragma unroll
    for (int n = 0; n < 4; ++n) acc[m][n] = f32x4{0.f, 0.f, 0.f, 0.f};
  bf16x8 ra0[4], rb0[4], ra1[4], rb1[4];
#define GLOAD(RA, RB, kt)                                                                          \
  {                                                                                                \
    const int kk_ = (kt_lo + (kt)) * 64 + c0 * 8;                                                  \
    _Pragma("unroll") for (int i = 0; i < 4; ++i) {                                                \
      RA[i] = al(row0 + r0 + i * 32, kk_, tn);                                                     \
      RB[i] = *(const bf16x8*)(Bt + (size_t)(col0 + r0 + i * 32) * ldb + kk_);                     \
    }                                                                                              \
  }
#define LWRITE(RA, RB, stage)                                                                      \
  {                                                                                                \
    _Pragma("unroll") for (int i = 0; i < 4; ++i) {                                                \
      const int r_ = r0 + i * 32;                                                                  \
      *(bf16x8*)(smem + (stage) * 32768 + r_ * 128 + ((c0 ^ (r_ & 7)) << 4)) = RA[i];             \
      *(bf16x8*)(smem + (stage) * 32768 + 16384 + r_ * 128 + ((c0 ^ keyB(r_)) << 4)) = RB[i];     \
    }                                                                                              \
  }
#define COMPUTE(stage)                                                                             \
  {                                                                                                \
    const char* sa_ = smem + (stage) * 32768;                                                      \
    const char* sb_ = sa_ + 16384;                                                                 \
    _Pragma("unroll") for (int ks = 0; ks < 2; ++ks) {                                             \
      bf16x8 af[4], bfr[4];                                                                        \
      const int c_ = ks * 4 + fq;                                                                  \
      _Pragma("unroll") for (int m = 0; m < 4; ++m)                                                \
        af[m] = *(const bf16x8*)(sa_ + (wm * 64 + m * 16 + fr) * 128 + ((c_ ^ (fr & 7)) << 4));    \
      _Pragma("unroll") for (int n = 0; n < 4; ++n)                                                \
        bfr[n] = *(const bf16x8*)(sb_ + (wn * 64 + (fr >> 2) * 16 + n * 4 + (fr & 3)) * 128 + ((c_ ^ kB) << 4)); \
      _Pragma("unroll") for (int m = 0; m < 4; ++m)                                                \
        _Pragma("unroll") for (int n = 0; n < 4; ++n)                                              \
          acc[m][n] = __builtin_amdgcn_mfma_f32_16x16x32_bf16(bfr[n], af[m], acc[m][n], 0, 0, 0);  \
    }                                                                                              \
  }
  if (DEEP) {
    GLOAD(ra0, rb0, 0);
    if (nk > 1) GLOAD(ra1, rb1, 1);
    LWRITE(ra0, rb0, 0);
    __syncthreads();
    if (nk > 2) GLOAD(ra0, rb0, 2);
    for (int kt = 0; kt < nk; kt += 2) {
      COMPUTE(0);
      if (kt + 1 < nk) LWRITE(ra1, rb1, 1);
      __syncthreads();
      if (kt + 3 < nk) GLOAD(ra1, rb1, kt + 3);
      if (kt + 1 < nk) {
        COMPUTE(1);
        if (kt + 2 < nk) LWRITE(ra0, rb0, 0);
        __syncthreads();
        if (kt + 4 < nk) GLOAD(ra0, rb0, kt + 4);
      }
    }
  } else {
    GLOAD(ra0, rb0, 0);
    LWRITE(ra0, rb0, 0);
    __syncthreads();
    for (int kt = 0; kt < nk; kt += 2) {
      if (kt + 1 < nk) GLOAD(ra0, rb0, kt + 1);
      COMPUTE(0);
      if (kt + 1 < nk) LWRITE(ra0, rb0, 1);
      __syncthreads();
      if (kt + 1 < nk) {
        if (kt + 2 < nk) GLOAD(ra0, rb0, kt + 2);
        COMPUTE(1);
        if (kt + 2 < nk) LWRITE(ra0, rb0, 0);
        __syncthreads();
      }
    }
  }
#undef GLOAD
#undef LWRITE
#undef COMPUTE
}

template <class AL, class EP, bool DEEP = true, bool SPLIT = false>
DEV void gemm_tiles(char* smem, const u16* __restrict__ Bt, int ldb, int K, int nM, int nN, int tile_off,
                    const AL& al, const EP& ep, float* part = nullptr) {
  const int tid = threadIdx.x, lane = tid & 63, wave = tid >> 6;
  const int wm = wave >> 1, wn = wave & 1, fr = lane & 15, fq = lane >> 4;
  const int ntiles = nM * nN;
  const int nslots = gridDim.x >> 3, xcd = blockIdx.x & 7;
  const int per = (ntiles + 7) >> 3;
  int slot = (int)(blockIdx.x >> 3) - (tile_off % nslots);
  if (slot < 0) slot += nslots;
  const int nkfull = K >> 6;
  const int full = SPLIT ? (per / nslots) * nslots : per;
  for (int L = slot; L < full; L += nslots) {
    const int gidx = xcd * per + L;
    if (gidx >= ntiles) break;
    const int grp = gidx / (GM * nN), rem = gidx - grp * (GM * nN);
    const int gm = min(GM, nM - grp * GM);
    const int tn = rem / gm, tm = grp * GM + (rem - tn * gm);
    const int row0 = tm * 128, col0 = tn * 128;
    f32x4 acc[4][4];
    gemm_kloop<AL, DEEP>(smem, Bt, ldb, al, row0, col0, tn, 0, nkfull, acc);
    ep(acc, row0 + wm * 64, col0 + wn * 64, lane);
  }
  if (SPLIT) {
    const int ntail = per - full;
    if (ntail > 0) {
      const int S = nslots / ntail;
      if (slot < ntail * S) {
        const int ti = slot / S, ksl = slot - ti * S;
        const int gidx = xcd * per + full + ti;
        if (gidx < ntiles) {
          const int kt_lo = (ksl * nkfull) / S, nk = ((ksl + 1) * nkfull) / S - kt_lo;
          const int grp = gidx / (GM * nN), rem = gidx - grp * (GM * nN);
          const int gm = min(GM, nM - grp * GM);
          const int tn = rem / gm, tm = grp * GM + (rem - tn * gm);
          f32x4 acc[4][4];
          gemm_kloop<AL, false>(smem, Bt, ldb, al, tm * 128, tn * 128, tn, kt_lo, nk, acc);
          float* dst = part + ((size_t)((xcd * ntail + ti) * S + ksl) << 14);
#pragma unroll
          for (int m = 0; m < 4; ++m)
#pragma unroll
            for (int n = 0; n < 4; ++n)
              *(f32x4*)(dst + (wm * 64 + m * 16 + fr) * 128 + wn * 64 + fq * 16 + n * 4) = acc[m][n];
        }
      }
    }
  }
}

template <class AL, class EP>
DEV void gemm256(char* smem, const u16* __restrict__ Bt, int ldb, int K, int nM, int nN, const AL& al, const EP& ep) {
  const int tid = threadIdx.x, lane = tid & 63, wave = tid >> 6;
  const int wm = wave >> 1, wn = wave & 1, fr = lane & 15, fq = lane >> 4;
  const int ntiles = nM * nN;
  const int nslots = gridDim.x >> 3, xcd = blockIdx.x & 7;
  const int per = (ntiles + 7) >> 3;
  const int slot = blockIdx.x >> 3;
  const int nk = K >> 5;
  const int lr = tid >> 2, lc = tid & 3;
  const int kA = (0x1320 >> (((fr >> 2) & 3) * 4)) & 3;
  const int kBb = (0x1320 >> ((fr >> 2) * 4)) & 3;
  for (int L = slot; L < per; L += nslots) {
    const int gidx = xcd * per + L;
    if (gidx >= ntiles) break;
    const int grp = gidx / (2 * nN), rem = gidx - grp * (2 * nN);
    const int gm = min(2, nM - grp * 2);
    const int tn = rem / gm, tm = grp * 2 + (rem - tn * gm);
    const int row0 = tm * 256, col0 = tn * 128;
    f32x4 acc[2][4][4];
#pragma unroll
    for (int h = 0; h < 2; ++h)
#pragma unroll
      for (int m = 0; m < 4; ++m)
#pragma unroll
        for (int n = 0; n < 4; ++n) acc[h][m][n] = f32x4{0.f, 0.f, 0.f, 0.f};
    bf16x8 ra0[4], rb0[2], ra1[4], rb1[2];
#define GLOAD2(ra, rb, kt)                                                                         \
  {                                                                                                \
    const int kk_ = (kt) * 32 + lc * 8;                                                            \
    _Pragma("unroll") for (int i = 0; i < 4; ++i) ra[i] = al(row0 + lr + i * 64, kk_, tn);         \
    _Pragma("unroll") for (int i = 0; i < 2; ++i)                                                  \
      rb[i] = *(const bf16x8*)(Bt + (size_t)(col0 + lr + i * 64) * ldb + kk_);                     \
  }
#define LWRITE2(ra, rb, stage)                                                                     \
  {                                                                                                \
    _Pragma("unroll") for (int i = 0; i < 4; ++i) {                                                \
      const int r_ = lr + i * 64;                                                                  \
      const int ka_ = (0x1320 >> (((r_ >> 2) & 3) * 4)) & 3;                                       \
      *(bf16x8*)(smem + (stage) * 24576 + r_ * 64 + ((lc ^ ka_) << 4)) = ra[i];                    \
    }                                                                                              \
    _Pragma("unroll") for (int i = 0; i < 2; ++i) {                                                \
      const int r_ = lr + i * 64;                                                                  \
      *(bf16x8*)(smem + (stage) * 24576 + 16384 + r_ * 64 + ((lc ^ ((0x1320 >> (((r_ >> 4) & 3) * 4)) & 3)) << 4)) = rb[i]; \
    }                                                                                              \
  }
#define COMPUTE2(stage)                                                                            \
  {                                                                                                \
    const char* sa_ = smem + (stage) * 24576;                                                      \
    const char* sb_ = sa_ + 16384;                                                                 \
    bf16x8 bfr[4];                                                                                 \
    _Pragma("unroll") for (int n = 0; n < 4; ++n)                                                  \
      bfr[n] = *(const bf16x8*)(sb_ + (wn * 64 + (fr >> 2) * 16 + n * 4 + (fr & 3)) * 64 + ((fq ^ kBb) << 4)); \
    _Pragma("unroll") for (int h = 0; h < 2; ++h) {                                                \
      bf16x8 af[4];                                                                                \
      _Pragma("unroll") for (int m = 0; m < 4; ++m)                                                \
        af[m] = *(const bf16x8*)(sa_ + (wm * 128 + h * 64 + m * 16 + fr) * 64 + ((fq ^ kA) << 4)); \
      _Pragma("unroll") for (int m = 0; m < 4; ++m)                                                \
        _Pragma("unroll") for (int n = 0; n < 4; ++n)                                              \
          acc[h][m][n] = __builtin_amdgcn_mfma_f32_16x16x32_bf16(bfr[n], af[m], acc[h][m][n], 0, 0, 0); \
    }                                                                                              \
  }
    GLOAD2(ra0, rb0, 0);
    if (nk > 1) GLOAD2(ra1, rb1, 1);
    LWRITE2(ra0, rb0, 0);
    __syncthreads();
    if (nk > 2) GLOAD2(ra0, rb0, 2);
    for (int kt = 0; kt < nk; kt += 2) {
      COMPUTE2(0);
      if (kt + 1 < nk) LWRITE2(ra1, rb1, 1);
      __syncthreads();
      if (kt + 3 < nk) GLOAD2(ra1, rb1, kt + 3);
      if (kt + 1 < nk) {
        COMPUTE2(1);
        if (kt + 2 < nk) LWRITE2(ra0, rb0, 0);
        __syncthreads();
        if (kt + 4 < nk) GLOAD2(ra0, rb0, kt + 4);
      }
    }
    ep(acc[0], row0 + wm * 128, col0 + wn * 64, lane);
    ep(acc[1], row0 + wm * 128 + 64, col0 + wn * 64, lane);
  }
#undef GLOAD2
#undef LWRITE2
#undef COMPUTE2
}

DEV void transpose_job(char* smem, const float* __restrict__ src, int K, int Nsrc, u16* __restrict__ dst, int dst_rows,
                       int perm, int& tile_off) {
  float* tile = (float*)smem;
  const int tid = threadIdx.x;
  const int G = gridDim.x;
  const int nkt = K >> 6, nnt = dst_rows >> 6;
  const int ntiles = nkt * nnt;
  int start = (int)blockIdx.x - (tile_off % G);
  if (start < 0) start += G;
  for (int t = start; t < ntiles; t += G) {
    const int kt = t % nkt, nt = t / nkt;
    const int k0 = kt * 64, n0 = nt * 64;
#pragma unroll
    for (int i = 0; i < 4; ++i) {
      const int id = tid + i * 256;
      const int kk = id >> 4, n4 = (id & 15) * 4;
      float4 v = {0.f, 0.f, 0.f, 0.f};
      if (n0 + n4 < Nsrc) {
        const f32x4 t4 = __builtin_nontemporal_load((const f32x4*)(src + (size_t)(k0 + kk) * Nsrc + n0 + n4));
        v.x = t4[0]; v.y = t4[1]; v.z = t4[2]; v.w = t4[3];
      }
      tile[kk * 65 + n4 + 0] = v.x; tile[kk * 65 + n4 + 1] = v.y;
      tile[kk * 65 + n4 + 2] = v.z; tile[kk * 65 + n4 + 3] = v.w;
    }
    __syncthreads();
#pragma unroll
    for (int i = 0; i < 2; ++i) {
      const int id = tid + i * 256;
      const int nn = id >> 3, k8 = (id & 7) * 8;
      bf16x8 o;
#pragma unroll
      for (int e = 0; e < 8; ++e) o[e] = f2bf(tile[(k8 + e) * 65 + nn]);
      int n = n0 + nn, R = n;
      if (perm) {
        const int up = n >= FF, g = up ? n - FF : n;
        const int w = g & 31, e = w & 7;
        R = (g >> 5) * 64 + (w >> 3) * 16 + ((e >> 2) + (up ? 2 : 0)) * 4 + (e & 3);
      }
      *(bf16x8*)(dst + (size_t)R * K + k0 + k8) = o;
    }
    __syncthreads();
  }
  tile_off += ntiles;
}

DEV void phase_prep(const Params& p, int layer, char* smem) {
  char* W = p.ws + OFF_W;
  int off = 0;
  for (int h = 0; h < 2; ++h) {
    transpose_job(smem, p.in[I_WI] + (size_t)(layer * 2 + h) * D * (2 * FF), D, 2 * FF,
                  (u16*)(W + (h ? W_WI1 : W_WI0)), 2 * FF, 1, off);
    transpose_job(smem, p.in[I_WO] + (size_t)(layer * 2 + h) * FF * D, FF, D, (u16*)(W + (h ? W_WO1 : W_WO0)), D, 0, off);
  }
  if (layer == 0) {
    transpose_job(smem, p.in[I_EVIN], D, PLD, (u16*)(W + W_IN), 4224, 0, off);
    transpose_job(smem, p.in[I_EVOUT], D, D, (u16*)(W + W_OUT), D, 0, off);
    {
      float* LBT = (float*)(p.ws + OFF_LBT);
      for (int i = blockIdx.x * 256 + threadIdx.x; i < 1024; i += gridDim.x * 256) {
        const float* lg = p.in[I_LB];
        const float l0 = lg[i], l1 = lg[1024 + i], l2 = lg[2048 + i];
        const float mx = fmaxf(l0, fmaxf(l1, l2));
        const float e0 = __expf(l0 - mx), e1 = __expf(l1 - mx), e2 = __expf(l2 - mx);
        LBT[i] = e0 / (e0 + e1 + e2);
      }
    }
    float* sc = (float*)smem;
    float* red = (float*)(smem + 20480);
    const int tid = threadIdx.x;
    __syncthreads();
    for (int i = tid; i < 5 * D; i += 256) {
      const int s = i >> 10, k = i & 1023;
      const float v = s < 4 ? p.in[I_C][s * D + k] : p.in[I_CCTX][k];
      sc[i] = silu(v);
    }
    __syncthreads();
    const int G = gridDim.x;
    int start = (int)blockIdx.x - (off % G);
    if (start < 0) start += G;
    float* MOD = (float*)(p.ws + OFF_MOD);
    for (int u = start; u < 288; u += G) {
      const int l = u / 144, j0 = (u % 144) * 64;
      const int jj = tid & 63, kg = tid >> 6;
      const float* w = p.in[I_ADAW] + (size_t)l * D * 9216 + j0 + jj;
      float a0 = 0.f, a1 = 0.f, a2 = 0.f, a3 = 0.f, a4 = 0.f;
#pragma unroll 8
      for (int k = kg * 256; k < kg * 256 + 256; ++k) {
        const float wv = __builtin_nontemporal_load(w + (size_t)k * 9216);
        a0 += sc[k] * wv; a1 += sc[1024 + k] * wv; a2 += sc[2048 + k] * wv; a3 += sc[3072 + k] * wv; a4 += sc[4096 + k] * wv;
      }
      float* rr = red + (kg * 64 + jj) * 5;
      rr[0] = a0; rr[1] = a1; rr[2] = a2; rr[3] = a3; rr[4] = a4;
      __syncthreads();
      for (int i = tid; i < 320; i += 256) {
        const int s = i / 64, j = i % 64;
        const float v = red[(0 * 64 + j) * 5 + s] + red[(1 * 64 + j) * 5 + s] + red[(2 * 64 + j) * 5 + s] + red[(3 * 64 + j) * 5 + s];
        MOD[(size_t)(l * 5 + s) * 9216 + j0 + j] = v + p.in[I_ADAB][l * 9216 + j0 + j];
      }
      __syncthreads();
    }
  } else {
    transpose_job(smem, p.in[I_WR], D, D, (u16*)(W + W_R), D, 0, off);
    transpose_job(smem, p.in[I_WK], D, D, (u16*)(W + W_K), D, 0, off);
    transpose_job(smem, p.in[I_WV], D, D, (u16*)(W + W_V), D, 0, off);
    transpose_job(smem, p.in[I_WOO], D, D, (u16*)(W + W_O), D, 0, off);
    for (int d = 0; d < 2; ++d) {
      transpose_job(smem, p.in[I_W1] + (size_t)d * D * 64, D, 64, (u16*)(W + W_W1) + (size_t)d * 64 * D, 64, 0, off);
      transpose_job(smem, p.in[I_A1] + (size_t)d * D * 64, D, 64, (u16*)(W + W_A1) + (size_t)d * 64 * D, 64, 0, off);
      transpose_job(smem, p.in[I_W2] + (size_t)d * 64 * D, 64, D, (u16*)(W + W_W2) + (size_t)d * D * 64, D, 0, off);
      transpose_job(smem, p.in[I_A2] + (size_t)d * 64 * D, 64, D, (u16*)(W + W_A2) + (size_t)d * D * 64, D, 0, off);
    }
    transpose_job(smem, p.in[I_G1], D, 128, (u16*)(W + W_G1), 128, 0, off);
    transpose_job(smem, p.in[I_G2], 128, D, (u16*)(W + W_G2), D, 0, off);
  }
}

DEV void phase_norm(const Params& p, const float* xlat, const float* xctx, const float* g, const float* modl,
                    int slot, int nrows, int fix_nM = 0, int fix_gidx = 0, float fix_scale = 0.f,
                    const float* fix_lat = nullptr, const float* fix_ctx = nullptr, const float* fix_modl = nullptr) {
  u16* H = (u16*)(p.ws + OFF_S + S_H);
  const int lane = threadIdx.x & 63;
  const int gw = blockIdx.x * 4 + (threadIdx.x >> 6), stride = gridDim.x * 4;
  for (int row = gw; row < nrows; row += stride) {
    const float4* src = (const float4*)xrow_ptr(xlat, xctx, row);
    const float* mm = modl + (size_t)mod_idx(row) * 9216 + slot * 3 * 1024;
    float4 v[4];
    float ss = 0.f;
#pragma unroll
    for (int i = 0; i < 4; ++i) {
      v[i] = src[lane + i * 64];
      if (fix_nM) {
        const int nN_ = 8, nslots_ = gridDim.x >> 3;
        const int per_ = (fix_nM * nN_ + 7) >> 3, full_ = (per_ / nslots_) * nslots_, ntail_ = per_ - full_;
        if (ntail_ > 0) {
          const int S_ = nslots_ / ntail_;
          const int c = (lane + i * 64) * 4, tn_ = c >> 7, tm_ = row >> 7;
          const int grp_ = tm_ / GM, gm_ = min(GM, fix_nM - grp_ * GM);
          const int gidx_ = grp_ * (GM * nN_) + tn_ * gm_ + (tm_ - grp_ * GM);
          const int xcd_ = gidx_ / per_, L_ = gidx_ - xcd_ * per_;
          if (L_ >= full_) {
            const float* part = (const float*)(p.ws + OFF_S + S_PART) + ((size_t)((xcd_ * ntail_ + (L_ - full_)) * S_) << 14) +
                                (row & 127) * 128 + (c & 127);
            float4 sum = {0.f, 0.f, 0.f, 0.f};
            for (int sl = 0; sl < S_; ++sl) {
              const float4 pv = *(const float4*)(part + ((size_t)sl << 14));
              sum.x += pv.x; sum.y += pv.y; sum.z += pv.z; sum.w += pv.w;
            }
            const float4 g4 = *(const float4*)(fix_modl + (size_t)mod_idx(row) * 9216 + fix_gidx * 1024 + c);
            const float4 xr = *(const float4*)(xrow_ptr(fix_lat, fix_ctx, row) + c);
            v[i].x = xr.x + fix_scale * g4.x * sum.x; v[i].y = xr.y + fix_scale * g4.y * sum.y;
            v[i].z = xr.z + fix_scale * g4.z * sum.z; v[i].w = xr.w + fix_scale * g4.w * sum.w;
            *(float4*)((float*)(p.ws + OFF_X) + (size_t)row * D + c) = v[i];
          }
        }
      }
      ss += v[i].x * v[i].x + v[i].y * v[i].y + v[i].z * v[i].z + v[i].w * v[i].w;
    }
    ss = red64(ss);
    const float rstd = rsqrtf(ss * (1.0f / 1024.0f) + 1e-6f);
#pragma unroll
    for (int i = 0; i < 4; ++i) {
      const int c = (lane + i * 64) * 4;
      const float4 gg = *(const float4*)(g + c);
      const float4 sh = *(const float4*)(mm + c);
      const float4 scl = *(const float4*)(mm + 1024 + c);
      bf16x4 o;
      o[0] = f2bf(v[i].x * rstd * gg.x * (1.0f + scl.x) + sh.x);
      o[1] = f2bf(v[i].y * rstd * gg.y * (1.0f + scl.y) + sh.y);
      o[2] = f2bf(v[i].z * rstd * gg.z * (1.0f + scl.z) + sh.z);
      o[3] = f2bf(v[i].w * rstd * gg.w * (1.0f + scl.w) + sh.w);
      *(bf16x4*)(H + (size_t)row * D + c) = o;
    }
  }
}

DEV void phase_final(const Params& p) {
  const float* X = (const float*)(p.ws + OFF_X);
  const float* g = p.in[I_FINALG];
  const int lane = threadIdx.x & 63;
  const int gw = blockIdx.x * 4 + (threadIdx.x >> 6), stride = gridDim.x * 4;
  for (int row = gw; row < MLAT; row += stride) {
    const float4* src = (const float4*)(X + (size_t)row * D);
    float4 v[4];
    float ss = 0.f;
#pragma unroll
    for (int i = 0; i < 4; ++i) {
      v[i] = src[lane + i * 64];
      ss += v[i].x * v[i].x + v[i].y * v[i].y + v[i].z * v[i].z + v[i].w * v[i].w;
    }
    ss = red64(ss);
    const float rstd = rsqrtf(ss * (1.0f / 1024.0f) + 1e-6f);
#pragma unroll
    for (int i = 0; i < 4; ++i) {
      const int c = (lane + i * 64) * 4;
      const float4 gg = *(const float4*)(g + c);
      float4 o;
      o.x = v[i].x * rstd * gg.x; o.y = v[i].y * rstd * gg.y; o.z = v[i].z * rstd * gg.z; o.w = v[i].w * rstd * gg.w;
      *(float4*)(p.out + (size_t)row * D + c) = o;
    }
  }
}

DEV int scan_row(int s, int b, int d) {
  if (s < 256) return MLAT + b * 256 + (d ? 255 - s : s);
  const int s2 = s - 256;
  return b * 4096 + (d ? 4095 - s2 : s2);
}

DEV bf16x8 ld8(const u16* P, int row, int col) { return *(const bf16x8*)(P + (size_t)row * PLD + col); }

DEV void even_scan_unit(const Params& p, int unit, char* smem) {
  const u16* P = (const u16*)(p.ws + OFF_S + S_P);
  float* dec = (float*)smem;
  float* kin = dec + 2048;
  float* qo = kin + 2048;
  float* vin = qo + 2048;
  float* cw = vin + 512;
  const int tid = threadIdx.x, lane = tid & 63;
  const bool ssd = unit >= 128;
  const int u = unit & 127;
  const int b = u >> 5;
  int d, colbase;
  int h = 0, vq = 0;
  int head = 0, ph = 0, grp = 0;
  if (!ssd) { h = (u >> 3) & 3; d = (u >> 2) & 1; vq = u & 3; colbase = h * 128 + vq * 32; }
  else { head = (u >> 2) & 7; d = (u >> 1) & 1; ph = u & 1; grp = head >> 2; colbase = 512 + head * 64 + ph * 32; }
  u16* O = (u16*)(p.ws + OFF_S + (d ? S_O1 : S_H));

  const int tok = tid >> 4, part = tid & 15;
  float lbv[8];
  float dtb = 0.f, aneg = 0.f;
  if (!ssd) {
    const float* lg = p.in[I_LB];
#pragma unroll
    for (int e = 0; e < 8; ++e) {
      const int c = d * 512 + h * 128 + part * 8 + e;
      const float l0 = lg[c], l1 = lg[1024 + c], l2 = lg[2048 + c];
      const float mx = fmaxf(l0, fmaxf(l1, l2));
      const float e0 = __expf(l0 - mx), e1 = __expf(l1 - mx), e2 = __expf(l2 - mx);
      lbv[e] = e0 / (e0 + e1 + e2);
    }
  } else {
    dtb = p.in[I_DTB][d * 8 + head];
    aneg = -__expf(p.in[I_ALOG][d * 8 + head]);
    for (int i = tid; i < 288; i += 256) {
      int c;
      if (i < 128) c = 512 + grp * 128 + i;
      else if (i < 256) c = 768 + grp * 128 + (i - 128);
      else c = head * 64 + ph * 32 + (i - 256);
      cw[i * 4 + 0] = p.in[I_CONVW][c];
      cw[i * 4 + 1] = p.in[I_CONVW][1024 + c];
      cw[i * 4 + 2] = p.in[I_CONVW][2048 + c];
      cw[i * 4 + 3] = p.in[I_CONVB][c];
    }
  }
  const int kp = lane & 15, vg = tid >> 4;
  float S[8][2];
#pragma unroll
  for (int a = 0; a < 8; ++a) { S[a][0] = 0.f; S[a][1] = 0.f; }

  const bf16x8 z8 = {0, 0, 0, 0, 0, 0, 0, 0};
  bf16x8 q0 = z8, q1 = z8, q2 = z8, q3 = z8, q4 = z8, q5 = z8, q6 = z8, q7 = z8, q8 = z8;
  short dtraw = 0, dtraw2 = 0;
  const int tok2 = (tid >> 2) & 15, part2 = tid & 3;
#define EV_ISSUE(c)                                                                              \
  {                                                                                              \
    const int row = scan_row((c) * 16 + tok, b, d);                                              \
    const int row2 = scan_row((c) * 16 + tok2, b, d);                                            \
    if (!ssd) {                                                                                  \
      q0 = ld8(P, row, 1024 + d * 512 + h * 128 + part * 8);                                     \
      q1 = ld8(P, row, h * 128 + part * 8);                                                      \
      q2 = ld8(P, row2, 512 + h * 128 + vq * 32 + part2 * 8);                                    \
    } else {                                                                                     \
      const bool lat = row < MLAT;                                                               \
      const int tpos = lat ? (row & 4095) : ((row - MLAT) & 255);                                \
      const int T = lat ? 4096 : 256;                                                            \
      const bool hm = tpos > 0, hp = tpos < T - 1;                                               \
      const int rm = hm ? row - 1 : row, rp = hp ? row + 1 : row;                                \
      const int cB = 3584 + grp * 128 + part * 8, cC = 3840 + grp * 128 + part * 8;              \
      q0 = ld8(P, rm, cB); q1 = ld8(P, row, cB); q2 = ld8(P, rp, cB);                            \
      q3 = ld8(P, rm, cC); q4 = ld8(P, row, cC); q5 = ld8(P, rp, cC);                            \
      if (!hm) { q0 = z8; q3 = z8; }                                                             \
      if (!hp) { q2 = z8; q5 = z8; }                                                             \
      dtraw = (short)P[(size_t)row * PLD + 4096 + d * 8 + head];                                 \
      const bool lat2 = row2 < MLAT;                                                             \
      const int tp2 = lat2 ? (row2 & 4095) : ((row2 - MLAT) & 255);                              \
      const int T2 = lat2 ? 4096 : 256;                                                          \
      const bool hm2 = tp2 > 0, hp2 = tp2 < T2 - 1;                                              \
      const int cX = 3072 + head * 64 + ph * 32 + part2 * 8;                                     \
      q6 = ld8(P, hm2 ? row2 - 1 : row2, cX); q7 = ld8(P, row2, cX); q8 = ld8(P, hp2 ? row2 + 1 : row2, cX); \
      if (!hm2) q6 = z8;                                                                         \
      if (!hp2) q8 = z8;                                                                         \
      dtraw2 = (short)P[(size_t)row2 * PLD + 4096 + d * 8 + head];                               \
    }                                                                                            \
  }
  __syncthreads();
  EV_ISSUE(0);
  const int NCH = (256 + 4096) / 16;
  for (int c = 0; c < NCH; ++c) {
    if (!ssd) {
      float fv[8], kv[8], qv[8];
#pragma unroll
      for (int e = 0; e < 8; ++e) {
        const float z = bf2f(q0[e]);
        const float sg = sigm(z);
        fv[e] = lbv[e] + (1.0f - lbv[e]) * sg;
        kv[e] = (1.0f - lbv[e]) * (1.0f - sg);
        qv[e] = silu(bf2f(q1[e]));
      }
      float* d0 = dec + tok * 128 + part * 8;
      float* k0 = kin + tok * 128 + part * 8;
      float* qq = qo + tok * 128 + part * 8;
      *(float4*)d0 = float4{fv[0], fv[1], fv[2], fv[3]}; *(float4*)(d0 + 4) = float4{fv[4], fv[5], fv[6], fv[7]};
      *(float4*)k0 = float4{kv[0], kv[1], kv[2], kv[3]}; *(float4*)(k0 + 4) = float4{kv[4], kv[5], kv[6], kv[7]};
      *(float4*)qq = float4{qv[0], qv[1], qv[2], qv[3]}; *(float4*)(qq + 4) = float4{qv[4], qv[5], qv[6], qv[7]};
      if (tid < 64) {
        float* vv = vin + (tid >> 2) * 32 + (tid & 3) * 8;
#pragma unroll
        for (int e = 0; e < 8; ++e) vv[e] = bf2f(q2[e]);
      }
    } else {
      const float dtv = bf2f(dtraw) + dtb;
      const float dt = dtv > 20.f ? dtv : __logf(1.0f + __expf(dtv));
      const float dc = __expf(dt * aneg);
      float bv[8], cv[8];
#pragma unroll
      for (int e = 0; e < 8; ++e) {
        const float4 wb = *(const float4*)(cw + (part * 8 + e) * 4);
        const float4 wc = *(const float4*)(cw + (128 + part * 8 + e) * 4);
        bv[e] = silu(wb.x * bf2f(q0[e]) + wb.y * bf2f(q1[e]) + wb.z * bf2f(q2[e]) + wb.w);
        cv[e] = silu(wc.x * bf2f(q3[e]) + wc.y * bf2f(q4[e]) + wc.z * bf2f(q5[e]) + wc.w);
      }
      float* d0 = dec + tok * 128 + part * 8;
      float* k0 = kin + tok * 128 + part * 8;
      float* qq = qo + tok * 128 + part * 8;
      *(float4*)d0 = float4{dc, dc, dc, dc}; *(float4*)(d0 + 4) = float4{dc, dc, dc, dc};
      *(float4*)k0 = float4{bv[0], bv[1], bv[2], bv[3]}; *(float4*)(k0 + 4) = float4{bv[4], bv[5], bv[6], bv[7]};
      *(float4*)qq = float4{cv[0], cv[1], cv[2], cv[3]}; *(float4*)(qq + 4) = float4{cv[4], cv[5], cv[6], cv[7]};
      if (tid < 64) {
        const float dtv2 = bf2f(dtraw2) + dtb;
        const float dt2 = dtv2 > 20.f ? dtv2 : __logf(1.0f + __expf(dtv2));
        float* vv = vin + (tid >> 2) * 32 + (tid & 3) * 8;
#pragma unroll
        for (int e = 0; e < 8; ++e) {
          const float4 wx = *(const float4*)(cw + (256 + (tid & 3) * 8 + e) * 4);
          vv[e] = dt2 * silu(wx.x * bf2f(q6[e]) + wx.y * bf2f(q7[e]) + wx.z * bf2f(q8[e]) + wx.w);
        }
      }
    }
    __syncthreads();
    if (c + 1 < NCH) EV_ISSUE(c + 1);
    float ok0 = 0.f, ok1 = 0.f;
#pragma unroll 4
    for (int t = 0; t < 16; ++t) {
      const float4 da = *(const float4*)(dec + t * 128 + kp * 8), db = *(const float4*)(dec + t * 128 + kp * 8 + 4);
      const float4 ka = *(const float4*)(kin + t * 128 + kp * 8), kb = *(const float4*)(kin + t * 128 + kp * 8 + 4);
      const float4 qa = *(const float4*)(qo + t * 128 + kp * 8), qb = *(const float4*)(qo + t * 128 + kp * 8 + 4);
      const float2 vv = *(const float2*)(vin + t * 32 + vg * 2);
      const float dd[8] = {da.x, da.y, da.z, da.w, db.x, db.y, db.z, db.w};
      const float kk[8] = {ka.x, ka.y, ka.z, ka.w, kb.x, kb.y, kb.z, kb.w};
      const float qq[8] = {qa.x, qa.y, qa.z, qa.w, qb.x, qb.y, qb.z, qb.w};
      float o0 = 0.f, o1 = 0.f;
#pragma unroll
      for (int a = 0; a < 8; ++a) {
        S[a][0] = dd[a] * S[a][0] + kk[a] * vv.x;
        S[a][1] = dd[a] * S[a][1] + kk[a] * vv.y;
        o0 += S[a][0] * qq[a];
        o1 += S[a][1] * qq[a];
      }
      o0 = red16(o0); o1 = red16(o1);
      ok0 = (kp == t) ? o0 : ok0;
      ok1 = (kp == t) ? o1 : ok1;
    }
    {
      const int row = scan_row(c * 16 + kp, b, d);
      bf16x2 ov; ov[0] = f2bf(ok0); ov[1] = f2bf(ok1);
      *(bf16x2*)(O + (size_t)row * D + colbase + vg * 2) = ov;
    }
    __syncthreads();
  }
}

#define MFMA16(a, b, c) __builtin_amdgcn_mfma_f32_16x16x32_bf16(a, b, c, 0, 0, 0)
DEV bf16x8 lds8(const u16* q) { return *(const bf16x8*)q; }

DEV void hgrn_chunk_unit(const Params& p, int u, char* smem) {
  const u16* P = (const u16*)(p.ws + OFF_S + S_P);
  u16* QH = (u16*)smem;
  u16* KH = QH + 4352;
  u16* QG = KH + 4352;
  u16* KTT = QG + 4352;
  u16* VT = KTT + 5120;
  u16* PB = VT + 1280;
  u16* ST = PB + 1280;
  float* TOT = (float*)(ST + 4352);
  float* DEC = TOT + 512;
  u16* RAWF = QG;
  u16* RAWQ = RAWF + 4096;
  const int tid = threadIdx.x, lane = tid & 63, wave = tid >> 6, fr = lane & 15, fq = lane >> 4;
  const int b = u >> 5, h = (u >> 3) & 3, d = (u >> 2) & 1, vq = u & 3;
  const int colbase = h * 128 + vq * 32;
  u16* O = (u16*)(p.ws + OFF_S + (d ? S_O1 : S_H));
  const int kp = tid & 63, g = tid >> 6, k0 = kp * 2;
  __syncthreads();
  for (int i = tid; i < 4352 / 2; i += 256) ((unsigned*)ST)[i] = 0u;
  f32x4 Sacc[2][2];
#pragma unroll
  for (int a = 0; a < 2; ++a)
#pragma unroll
    for (int c2 = 0; c2 < 2; ++c2) Sacc[a][c2] = f32x4{0.f, 0.f, 0.f, 0.f};
  bf16x8 pf0, pf1, pq0, pq1, pv;
  const int tokA = tid >> 4, k8 = (tid & 15) * 8;
  const int tokv = (tid >> 2) & 31, v8 = (tid & 3) * 8;
#define HG_ISSUE(c)                                                                         \
  {                                                                                         \
    const int r0_ = scan_row((c) * 32 + tokA, b, d), r1_ = scan_row((c) * 32 + tokA + 16, b, d); \
    pf0 = ld8(P, r0_, 1024 + d * 512 + h * 128 + k8); pf1 = ld8(P, r1_, 1024 + d * 512 + h * 128 + k8); \
    pq0 = ld8(P, r0_, h * 128 + k8); pq1 = ld8(P, r1_, h * 128 + k8);                       \
    pv = ld8(P, scan_row((c) * 32 + tokv, b, d), 512 + h * 128 + vq * 32 + v8);             \
  }
  HG_ISSUE(0);
  const int NCH = (256 + 4096) / 32;
  for (int c = 0; c < NCH; ++c) {
    *(bf16x8*)(RAWF + tokA * 128 + k8) = pf0; *(bf16x8*)(RAWF + (tokA + 16) * 128 + k8) = pf1;
    *(bf16x8*)(RAWQ + tokA * 128 + k8) = pq0; *(bf16x8*)(RAWQ + (tokA + 16) * 128 + k8) = pq1;
    if (tid < 128) {
#pragma unroll
      for (int e = 0; e < 8; ++e) VT[(v8 + e) * 40 + tokv] = (u16)pv[e];
    }
    __syncthreads();
    if (c + 1 < NCH) HG_ISSUE(c + 1);
    float qv[2][8], kv[2][8], cm[2][8];
    float cum0 = 1.f, cum1 = 1.f;
#pragma unroll
    for (int t = 0; t < 8; ++t) {
      const int tok = g * 8 + t;
      const bf16x2 rf = *(const bf16x2*)(RAWF + tok * 128 + k0);
      const bf16x2 rq2 = *(const bf16x2*)(RAWQ + tok * 128 + k0);
      kv[0][t] = bf2f(rf[0]); kv[1][t] = bf2f(rf[1]);
      qv[0][t] = bf2f(rq2[0]); qv[1][t] = bf2f(rq2[1]);
      cum0 *= 1.0f - kv[0][t]; cum1 *= 1.0f - kv[1][t];
      cm[0][t] = cum0; cm[1][t] = cum1;
    }
    *(float2*)(TOT + g * 128 + k0) = float2{cum0, cum1};
    __syncthreads();
    {
      const float2 ta = *(const float2*)(TOT + k0), tb = *(const float2*)(TOT + 128 + k0);
      const float2 tc = *(const float2*)(TOT + 256 + k0), td = *(const float2*)(TOT + 384 + k0);
      const float tt[2][4] = {{ta.x, tb.x, tc.x, td.x}, {ta.y, tb.y, tc.y, td.y}};
      bf16x8 ktv[2];
      float e0s[2], e1s[2];
#pragma unroll
      for (int cc = 0; cc < 2; ++cc) {
        const float pre = (g > 0 ? tt[cc][0] : 1.f) * (g > 1 ? tt[cc][1] : 1.f) * (g > 2 ? tt[cc][2] : 1.f);
        e0s[cc] = 1.0f;
        e1s[cc] = tt[cc][0] * tt[cc][1] * tt[cc][2] * tt[cc][3];
        const float off = pre;
#pragma unroll
        for (int t = 0; t < 8; ++t) {
          const float eq = cm[cc][t] * off, ek = __builtin_amdgcn_rcpf(eq);
          qv[cc][t] = qv[cc][t] * eq;
          kv[cc][t] = kv[cc][t] * ek;
          ktv[cc][t] = f2bf(kv[cc][t] * e1s[cc]);
        }
      }
#pragma unroll
      for (int t = 0; t < 8; ++t) {
        const int tok = g * 8 + t;
        bf16x2 o;
        o[0] = f2bf(kv[0][t]); o[1] = f2bf(kv[1][t]);
        *(bf16x2*)(KH + tok * 136 + k0) = o;
        o[0] = f2bf(qv[0][t]); o[1] = f2bf(qv[1][t]);
        *(bf16x2*)(QG + tok * 136 + k0) = o;
      }
      *(bf16x8*)(KTT + k0 * 40 + g * 8) = ktv[0];
      *(bf16x8*)(KTT + (k0 + 1) * 40 + g * 8) = ktv[1];
      if (g == 0) *(float2*)(DEC + k0) = float2{e0s[0] * e1s[0], e0s[1] * e1s[1]};
    }
    __syncthreads();
    if (wave < 3) {
      const int lt = wave ? 1 : 0, st = wave == 2 ? 1 : 0;
      f32x4 acc = {0.f, 0.f, 0.f, 0.f};
#pragma unroll
      for (int ks = 0; ks < 4; ++ks)
        acc = MFMA16(lds8(QG + (lt * 16 + fr) * 136 + ks * 32 + fq * 8), lds8(KH + (st * 16 + fr) * 136 + ks * 32 + fq * 8), acc);
#pragma unroll
      for (int j = 0; j < 4; ++j) {
        const int l = lt * 16 + fq * 4 + j, s2 = st * 16 + fr;
        PB[l * 40 + s2] = (u16)f2bf(s2 <= l ? acc[j] : 0.f);
      }
    } else {
#pragma unroll
      for (int j = 0; j < 4; ++j) PB[(fq * 4 + j) * 40 + 16 + fr] = 0;
    }
    __syncthreads();
    {
      const int lt = wave >> 1, vt = wave & 1;
      f32x4 acc = {0.f, 0.f, 0.f, 0.f};
#pragma unroll
      for (int ks = 0; ks < 4; ++ks)
        acc = MFMA16(lds8(QG + (lt * 16 + fr) * 136 + ks * 32 + fq * 8), lds8(ST + (vt * 16 + fr) * 136 + ks * 32 + fq * 8), acc);
      acc = MFMA16(lds8(PB + (lt * 16 + fr) * 40 + fq * 8), lds8(VT + (vt * 16 + fr) * 40 + fq * 8), acc);
#pragma unroll
      for (int j = 0; j < 4; ++j) {
        const int row = scan_row(c * 32 + lt * 16 + fq * 4 + j, b, d);
        O[(size_t)row * D + colbase + vt * 16 + fr] = (u16)f2bf(acc[j]);
      }
#pragma unroll
      for (int a = 0; a < 2; ++a) {
        const int kt = wave * 2 + a;
        const float4 dc = *(const float4*)(DEC + kt * 16 + fq * 4);
        const bf16x8 af = lds8(KTT + (kt * 16 + fr) * 40 + fq * 8);
#pragma unroll
        for (int v2 = 0; v2 < 2; ++v2) {
          Sacc[a][v2][0] *= dc.x; Sacc[a][v2][1] *= dc.y; Sacc[a][v2][2] *= dc.z; Sacc[a][v2][3] *= dc.w;
          Sacc[a][v2] = MFMA16(af, lds8(VT + (v2 * 16 + fr) * 40 + fq * 8), Sacc[a][v2]);
        }
      }
    }
    __syncthreads();
#pragma unroll
    for (int a = 0; a < 2; ++a)
#pragma unroll
      for (int v2 = 0; v2 < 2; ++v2) {
        bf16x4 o;
#pragma unroll
        for (int j = 0; j < 4; ++j) o[j] = f2bf(Sacc[a][v2][j]);
        *(bf16x4*)(ST + (v2 * 16 + fr) * 136 + (wave * 2 + a) * 16 + fq * 4) = o;
      }
  }
  __syncthreads();
#undef HG_ISSUE
}

DEV void ssd_chunk_unit(const Params& p, int u, char* smem) {
  const u16* P = (const u16*)(p.ws + OFF_S + S_P);
  const u16* F = (const u16*)(p.ws + OFF_S + S_F);
  u16* CM = (u16*)smem;
  u16* BM = CM + 4352;
  u16* V1 = BM + 4352;
  u16* V2 = V1 + 1280;
  u16* PB = V2 + 1280;
  u16* ST = PB + 1280;
  float* LG = (float*)(ST + 4352);
  float* BC = LG + 32;
  const int tid = threadIdx.x, lane = tid & 63, wave = tid >> 6, fr = lane & 15, fq = lane >> 4;
  const int b = u >> 5, head = (u >> 2) & 7, d = (u >> 1) & 1, ph = u & 1, grp = head >> 2;
  const int colbase = 512 + head * 64 + ph * 32;
  u16* O = (u16*)(p.ws + OFF_S + (d ? S_O1 : S_H));
  const float dtb = p.in[I_DTB][d * 8 + head];
  const float aneg = -__expf(p.in[I_ALOG][d * 8 + head]);
  __syncthreads();
  for (int i = tid; i < 4352 / 2; i += 256) ((unsigned*)ST)[i] = 0u;
  f32x4 Sacc[2][2];
#pragma unroll
  for (int a = 0; a < 2; ++a)
#pragma unroll
    for (int c2 = 0; c2 < 2; ++c2) Sacc[a][c2] = f32x4{0.f, 0.f, 0.f, 0.f};
  const int tok = tid >> 3, part = tid & 7, n16 = part * 16;
  bf16x8 b0, b1, c0, c1;
  bf16x4 x0;
  short dtraw;
#define SD_ISSUE(c)                                                                         \
  {                                                                                         \
    const int row = scan_row((c) * 32 + tok, b, d);                                         \
    const u16* fr_ = F + (size_t)row * D;                                                   \
    b0 = *(const bf16x8*)(fr_ + 512 + grp * 128 + n16); b1 = *(const bf16x8*)(fr_ + 512 + grp * 128 + n16 + 8); \
    c0 = *(const bf16x8*)(fr_ + 768 + grp * 128 + n16); c1 = *(const bf16x8*)(fr_ + 768 + grp * 128 + n16 + 8); \
    x0 = *(const bf16x4*)(fr_ + head * 64 + ph * 32 + part * 4);                            \
    dtraw = (short)P[(size_t)row * PLD + 4096 + d * 8 + head];                              \
  }
  SD_ISSUE(0);
  __syncthreads();
  const int NCH = (256 + 4096) / 32;
  for (int c = 0; c < NCH; ++c) {
    const float dtv = bf2f(dtraw) + dtb;
    const float dt = dtv > 20.f ? dtv : __logf(1.0f + __expf(dtv));
    float dtx[4];
    *(bf16x8*)(BM + tok * 136 + n16) = b0; *(bf16x8*)(BM + tok * 136 + n16 + 8) = b1;
    *(bf16x8*)(CM + tok * 136 + n16) = c0; *(bf16x8*)(CM + tok * 136 + n16 + 8) = c1;
    {
#pragma unroll
      for (int e = 0; e < 4; ++e) { dtx[e] = dt * bf2f(x0[e]); V1[(part * 4 + e) * 40 + tok] = (u16)f2bf(dtx[e]); }
    }
    if (part == 0) LG[tok] = dt * aneg;
    __syncthreads();
    if (c + 1 < NCH) SD_ISSUE(c + 1);
    float bt = 0.f, tot = 0.f;
#pragma unroll
    for (int i4 = 0; i4 < 8; ++i4) {
      const float4 v4 = *(const float4*)(LG + i4 * 4);
      const float vv[4] = {v4.x, v4.y, v4.z, v4.w};
#pragma unroll
      for (int e = 0; e < 4; ++e) {
        tot += vv[e];
        bt += (i4 * 4 + e <= tok) ? vv[e] : 0.f;
      }
    }
    if (part == 0) BC[tok] = bt;
    {
      const float e2 = __expf(tot - bt);
#pragma unroll
      for (int e = 0; e < 4; ++e) V2[(part * 4 + e) * 40 + tok] = (u16)f2bf(e2 * dtx[e]);
    }
    const float decS = __expf(tot);
    __syncthreads();
    if (wave < 3) {
      const int lt = wave ? 1 : 0, st = wave == 2 ? 1 : 0;
      f32x4 acc = {0.f, 0.f, 0.f, 0.f};
#pragma unroll
      for (int ks = 0; ks < 4; ++ks)
        acc = MFMA16(lds8(CM + (lt * 16 + fr) * 136 + ks * 32 + fq * 8), lds8(BM + (st * 16 + fr) * 136 + ks * 32 + fq * 8), acc);
      const float4 bl = *(const float4*)(BC + lt * 16 + fq * 4);
      const float bs = BC[st * 16 + fr];
      const float blv[4] = {bl.x, bl.y, bl.z, bl.w};
#pragma unroll
      for (int j = 0; j < 4; ++j) {
        const int l = lt * 16 + fq * 4 + j, s2 = st * 16 + fr;
        PB[l * 40 + s2] = (u16)f2bf(s2 <= l ? acc[j] * __expf(blv[j] - bs) : 0.f);
      }
    } else {
#pragma unroll
      for (int j = 0; j < 4; ++j) PB[(fq * 4 + j) * 40 + 16 + fr] = 0;
    }
    __syncthreads();
    {
      const int lt = wave >> 1, vt = wave & 1;
      f32x4 acc = {0.f, 0.f, 0.f, 0.f};
#pragma unroll
      for (int ks = 0; ks < 4; ++ks)
        acc = MFMA16(lds8(CM + (lt * 16 + fr) * 136 + ks * 32 + fq * 8), lds8(ST + (vt * 16 + fr) * 136 + ks * 32 + fq * 8), acc);
      const float4 bl = *(const float4*)(BC + lt * 16 + fq * 4);
      acc[0] *= __expf(bl.x); acc[1] *= __expf(bl.y); acc[2] *= __expf(bl.z); acc[3] *= __expf(bl.w);
      bf16x8 v2f[2], bt8[2];
      const bf16x8 v1f = lds8(V1 + (vt * 16 + fr) * 40 + fq * 8);
      v2f[0] = lds8(V2 + fr * 40 + fq * 8);
      v2f[1] = lds8(V2 + (16 + fr) * 40 + fq * 8);
#pragma unroll
      for (int e = 0; e < 8; ++e) {
        bt8[0][e] = (short)BM[(fq * 8 + e) * 136 + (wave * 2) * 16 + fr];
        bt8[1][e] = (short)BM[(fq * 8 + e) * 136 + (wave * 2 + 1) * 16 + fr];
      }
      acc = MFMA16(lds8(PB + (lt * 16 + fr) * 40 + fq * 8), v1f, acc);
#pragma unroll
      for (int j = 0; j < 4; ++j) {
        const int row = scan_row(c * 32 + lt * 16 + fq * 4 + j, b, d);
        O[(size_t)row * D + colbase + vt * 16 + fr] = (u16)f2bf(acc[j]);
      }
#pragma unroll
      for (int a = 0; a < 2; ++a)
#pragma unroll
        for (int v2 = 0; v2 < 2; ++v2) {
          Sacc[a][v2][0] *= decS; Sacc[a][v2][1] *= decS; Sacc[a][v2][2] *= decS; Sacc[a][v2][3] *= decS;
          Sacc[a][v2] = MFMA16(bt8[a], v2f[v2], Sacc[a][v2]);
        }
    }
    __syncthreads();
#pragma unroll
    for (int a = 0; a < 2; ++a)
#pragma unroll
      for (int v2 = 0; v2 < 2; ++v2) {
        bf16x4 o;
#pragma unroll
        for (int j = 0; j < 4; ++j) o[j] = f2bf(Sacc[a][v2][j]);
        *(bf16x4*)(ST + (v2 * 16 + fr) * 136 + (wave * 2 + a) * 16 + fq * 4) = o;
      }
  }
  __syncthreads();
#undef SD_ISSUE
}

DEV void phase_xbc_conv(const Params& p, int nrows) {
  const u16* P = (const u16*)(p.ws + OFF_S + S_P);
  u16* F = (u16*)(p.ws + OFF_S + S_F);
  const int lane = threadIdx.x & 63;
  const int gw = blockIdx.x * 4 + (threadIdx.x >> 6), stride = gridDim.x * 4;
  const float* cw = p.in[I_CONVW];
  const float* cb = p.in[I_CONVB];
  for (int row = gw; row < nrows; row += stride) {
    const bool lat = row < MLAT;
    const int tpos = lat ? (row & 4095) : ((row - MLAT) & 255);
    const int T = lat ? 4096 : 256;
    const bool hm = tpos > 0, hp = tpos < T - 1;
    const float fm = hm ? 1.f : 0.f, fp = hp ? 1.f : 0.f;
    const int rm = hm ? row - 1 : row, rp = hp ? row + 1 : row;
#pragma unroll
    for (int hh = 0; hh < 2; ++hh) {
      const int c = lane * 16 + hh * 8;
      const bf16x8 xm = ld8(P, rm, 3072 + c), x0 = ld8(P, row, 3072 + c), xp = ld8(P, rp, 3072 + c);
      float w0[8], w1[8], w2[8], bb[8];
      *(float4*)(w0) = *(const float4*)(cw + c); *(float4*)(w0 + 4) = *(const float4*)(cw + c + 4);
      *(float4*)(w1) = *(const float4*)(cw + 1024 + c); *(float4*)(w1 + 4) = *(const float4*)(cw + 1024 + c + 4);
      *(float4*)(w2) = *(const float4*)(cw + 2048 + c); *(float4*)(w2 + 4) = *(const float4*)(cw + 2048 + c + 4);
      *(float4*)(bb) = *(const float4*)(cb + c); *(float4*)(bb + 4) = *(const float4*)(cb + c + 4);
      bf16x8 o;
#pragma unroll
      for (int e = 0; e < 8; ++e)
        o[e] = f2bf(silu(w0[e] * fm * bf2f(xm[e]) + w1[e] * bf2f(x0[e]) + w2[e] * fp * bf2f(xp[e]) + bb[e]));
      *(bf16x8*)(F + (size_t)row * D + c) = o;
    }
  }
}

DEV void phase_even_finish(const Params& p, int nrows) {
  const u16* P = (const u16*)(p.ws + OFF_S + S_P);
  u16* O0 = (u16*)(p.ws + OFF_S + S_H);
  const u16* O1 = (const u16*)(p.ws + OFF_S + S_O1);
  const int lane = threadIdx.x & 63;
  const int gw = blockIdx.x * 4 + (threadIdx.x >> 6), stride = gridDim.x * 4;
  const int c = lane * 8;
  for (int row = gw; row < nrows; row += stride) {
    {
      const bf16x8 a = *(const bf16x8*)(O0 + (size_t)row * D + c);
      const bf16x8 bq = *(const bf16x8*)(O1 + (size_t)row * D + c);
      const bf16x8 g = ld8(P, row, 2048 + c);
      float o[8], ss = 0.f;
#pragma unroll
      for (int e = 0; e < 8; ++e) { o[e] = bf2f(a[e]) + bf2f(bq[e]); ss += o[e] * o[e]; }
      ss = red16(ss);
      const float rstd = rsqrtf(ss * (1.0f / 128.0f) + 1e-6f);
      float hg[8];
      *(float4*)(hg) = *(const float4*)(p.in[I_HGRNG] + (c & 127)); *(float4*)(hg + 4) = *(const float4*)(p.in[I_HGRNG] + (c & 127) + 4);
      bf16x8 out;
#pragma unroll
      for (int e = 0; e < 8; ++e)
        out[e] = f2bf(o[e] * rstd * hg[e] * silu(bf2f(g[e])));
      *(bf16x8*)(O0 + (size_t)row * D + c) = out;
    }
    {
      const bf16x8 a = *(const bf16x8*)(O0 + (size_t)row * D + 512 + c);
      const bf16x8 bq = *(const bf16x8*)(O1 + (size_t)row * D + 512 + c);
      const bf16x8 z = ld8(P, row, 2560 + c);
      const bf16x8 xc = *(const bf16x8*)((const u16*)(p.ws + OFF_S + S_F) + (size_t)row * D + c);
      const float dsk = p.in[I_SSDD][c >> 6];
      float o[8], ss = 0.f;
#pragma unroll
      for (int e = 0; e < 8; ++e) {
        const float xs = bf2f(xc[e]);
        o[e] = (bf2f(a[e]) + bf2f(bq[e]) + dsk * xs) * silu(bf2f(z[e]));
        ss += o[e] * o[e];
      }
      ss = red16(ss);
      ss += __shfl_xor(ss, 16);
      const float rstd = rsqrtf(ss * (1.0f / 256.0f) + 1e-6f);
      float sg[8];
      *(float4*)(sg) = *(const float4*)(p.in[I_SSDG] + c); *(float4*)(sg + 4) = *(const float4*)(p.in[I_SSDG] + c + 4);
      bf16x8 out;
#pragma unroll
      for (int e = 0; e < 8; ++e) out[e] = f2bf(o[e] * rstd * sg[e]);
      *(bf16x8*)(O0 + (size_t)row * D + 512 + c) = out;
    }
  }
}

DEV void odd_scan_unit(const Params& p, int unit, char* smem) {
  float* wl = (float*)smem;
  float* kl = wl + 1024;
  float* al = kl + 1024;
  float* bl = al + 1024;
  float* rl = bl + 1024;
  float* at = rl + 1024;
  float* vl = at + 1024;
  const int tid = threadIdx.x, lane = tid & 63, wave = tid >> 6;
  const int fr = lane & 15, fq = lane >> 4;
  const int b = unit >> 6, head = (unit >> 2) & 15, d = (unit >> 1) & 1, rh = unit & 1;
  const char* S = p.ws + OFF_S;
  const u16* R = (const u16*)(S + S_R);
  const u16* Kb = (const u16*)(S + S_K);
  const u16* V = (const u16*)(S + S_V);
  const u16* LORA = (const u16*)(S + S_LORA);
  float* BON = (float*)(S + S_BON) + (size_t)d * MTOT * 16;
  u16* Y = (u16*)(S + (d ? S_Y1 : S_H));
  const u16* W2T = (const u16*)(p.ws + OFF_W + W_W2) + (size_t)d * D * 64;
  const u16* A2T = (const u16*)(p.ws + OFF_W + W_A2) + (size_t)d * D * 64;
  const int ncol = head * 64 + wave * 16 + fr;
  bf16x8 bw[2], ba[2];
#pragma unroll
  for (int ks = 0; ks < 2; ++ks) {
    bw[ks] = *(const bf16x8*)(W2T + (size_t)ncol * 64 + ks * 32 + fq * 8);
    ba[ks] = *(const bf16x8*)(A2T + (size_t)ncol * 64 + ks * 32 + fq * 8);
  }
  const float w0c = p.in[I_W0][d * D + ncol], a0c = p.in[I_A0][d * D + ncol];
  const int tok = tid >> 4, c4 = (tid & 15) * 4;
  float kkc[4], kac[4], rkc[4];
#pragma unroll
  for (int e = 0; e < 4; ++e) {
    kkc[e] = p.in[I_KK][head * 64 + c4 + e];
    kac[e] = p.in[I_KA][head * 64 + c4 + e];
    rkc[e] = p.in[I_RK][head * 64 + c4 + e];
  }
  const int jp = lane & 7, il = tid >> 3;
  float St[8];
#pragma unroll
  for (int j = 0; j < 8; ++j) St[j] = 0.f;

  bf16x8 fa0, fa1, fb0, fb1;
  bf16x4 kr, rr;
  bf16x2 vr;
#define OD_ISSUE(c)                                                                              \
  {                                                                                              \
    const int rowA = scan_row((c) * 16 + fr, b, d);                                              \
    fa0 = *(const bf16x8*)(LORA + (size_t)rowA * LLD + d * 64 + fq * 8);                         \
    fa1 = *(const bf16x8*)(LORA + (size_t)rowA * LLD + d * 64 + 32 + fq * 8);                    \
    fb0 = *(const bf16x8*)(LORA + (size_t)rowA * LLD + 128 + d * 64 + fq * 8);                   \
    fb1 = *(const bf16x8*)(LORA + (size_t)rowA * LLD + 128 + d * 64 + 32 + fq * 8);              \
    const int rowE = scan_row((c) * 16 + tok, b, d);                                             \
    kr = *(const bf16x4*)(Kb + (size_t)rowE * D + head * 64 + c4);                               \
    rr = *(const bf16x4*)(R + (size_t)rowE * D + head * 64 + c4);                                \
    vr = *(const bf16x2*)(V + (size_t)rowE * D + head * 64 + rh * 32 + (tid & 15) * 2);          \
  }
  OD_ISSUE(0);
  const int NCH = (256 + 4096) / 16;
  for (int c = 0; c < NCH; ++c) {
    f32x4 accw = {0.f, 0.f, 0.f, 0.f}, acca = {0.f, 0.f, 0.f, 0.f};
    accw = __builtin_amdgcn_mfma_f32_16x16x32_bf16(fa0, bw[0], accw, 0, 0, 0);
    accw = __builtin_amdgcn_mfma_f32_16x16x32_bf16(fa1, bw[1], accw, 0, 0, 0);
    acca = __builtin_amdgcn_mfma_f32_16x16x32_bf16(fb0, ba[0], acca, 0, 0, 0);
    acca = __builtin_amdgcn_mfma_f32_16x16x32_bf16(fb1, ba[1], acca, 0, 0, 0);
#pragma unroll
    for (int j = 0; j < 4; ++j) {
      const int t = fq * 4 + j, cc = wave * 16 + fr;
      const float zw = w0c + accw[j];
      wl[t * 64 + cc] = __expf(-0.6065306597126334f * sigm(zw));
      at[t * 64 + cc] = sigm(a0c + acca[j]);
    }
    __syncthreads();
    {
      const float4 a4 = *(const float4*)(at + tok * 64 + c4);
      const float av[4] = {a4.x, a4.y, a4.z, a4.w};
      float kku[4], kd[4], rv[4], ss = 0.f, bsum = 0.f;
#pragma unroll
      for (int e = 0; e < 4; ++e) {
        const float k = bf2f(kr[e]);
        rv[e] = bf2f(rr[e]);
        kku[e] = k * kkc[e];
        ss += kku[e] * kku[e];
        kd[e] = k * (1.0f + (av[e] - 1.0f) * kac[e]);
        bsum += rv[e] * kd[e] * rkc[e];
      }
      ss = red16(ss);
      bsum = red16(bsum);
      const float inv = rsqrtf(fmaxf(ss, 1e-24f));
      const int row = scan_row(c * 16 + tok, b, d);
      if ((tid & 15) == 0 && rh == 0) BON[(size_t)row * 16 + head] = bsum;
      float4 ko, ao, bo, ro;
      ko.x = kd[0]; ko.y = kd[1]; ko.z = kd[2]; ko.w = kd[3];
      ao.x = -kku[0] * inv; ao.y = -kku[1] * inv; ao.z = -kku[2] * inv; ao.w = -kku[3] * inv;
      bo.x = -ao.x * av[0]; bo.y = -ao.y * av[1]; bo.z = -ao.z * av[2]; bo.w = -ao.w * av[3];
      ro.x = rv[0]; ro.y = rv[1]; ro.z = rv[2]; ro.w = rv[3];
      *(float4*)(kl + tok * 64 + c4) = ko;
      *(float4*)(al + tok * 64 + c4) = ao;
      *(float4*)(bl + tok * 64 + c4) = bo;
      *(float4*)(rl + tok * 64 + c4) = ro;
      float2 vo; vo.x = bf2f(vr[0]); vo.y = bf2f(vr[1]);
      *(float2*)(vl + tok * 32 + (tid & 15) * 2) = vo;
    }
    __syncthreads();
    if (c + 1 < NCH) OD_ISSUE(c + 1);
    float yk0 = 0.f, yk1 = 0.f;
#pragma unroll 2
    for (int t = 0; t < 16; ++t) {
      const float4 w_a = *(const float4*)(wl + t * 64 + jp * 8), w_b = *(const float4*)(wl + t * 64 + jp * 8 + 4);
      const float4 k_a = *(const float4*)(kl + t * 64 + jp * 8), k_b = *(const float4*)(kl + t * 64 + jp * 8 + 4);
      const float4 a_a = *(const float4*)(al + t * 64 + jp * 8), a_b = *(const float4*)(al + t * 64 + jp * 8 + 4);
      const float4 b_a = *(const float4*)(bl + t * 64 + jp * 8), b_b = *(const float4*)(bl + t * 64 + jp * 8 + 4);
      const float4 r_a = *(const float4*)(rl + t * 64 + jp * 8), r_b = *(const float4*)(rl + t * 64 + jp * 8 + 4);
      const float vi = vl[t * 32 + il];
      const float ww[8] = {w_a.x, w_a.y, w_a.z, w_a.w, w_b.x, w_b.y, w_b.z, w_b.w};
      const float kk[8] = {k_a.x, k_a.y, k_a.z, k_a.w, k_b.x, k_b.y, k_b.z, k_b.w};
      const float aa[8] = {a_a.x, a_a.y, a_a.z, a_a.w, a_b.x, a_b.y, a_b.z, a_b.w};
      const float bb[8] = {b_a.x, b_a.y, b_a.z, b_a.w, b_b.x, b_b.y, b_b.z, b_b.w};
      const float rq[8] = {r_a.x, r_a.y, r_a.z, r_a.w, r_b.x, r_b.y, r_b.z, r_b.w};
      float sa = 0.f;
#pragma unroll
      for (int j = 0; j < 8; ++j) sa += St[j] * aa[j];
      sa = red8(sa);
      float y = 0.f;
#pragma unroll
      for (int j = 0; j < 8; ++j) {
        St[j] = St[j] * ww[j] + sa * bb[j] + vi * kk[j];
        y += St[j] * rq[j];
      }
      y = red8(y);
      yk0 = (jp == t) ? y : yk0;
      yk1 = (jp + 8 == t) ? y : yk1;
    }
    {
      const int row0 = scan_row(c * 16 + jp, b, d), row1 = scan_row(c * 16 + 8 + jp, b, d);
      Y[(size_t)row0 * D + head * 64 + rh * 32 + il] = (u16)f2bf(yk0);
      Y[(size_t)row1 * D + head * 64 + rh * 32 + il] = (u16)f2bf(yk1);
    }
    __syncthreads();
  }
}

DEV void phase_odd_finish(const Params& p, int nrows) {
  const char* S = p.ws + OFF_S;
  u16* Y0 = (u16*)(p.ws + OFF_S + S_H);
  const u16* Y1 = (const u16*)(S + S_Y1);
  const u16* V = (const u16*)(S + S_V);
  const u16* Gb = (const u16*)(S + S_G);
  const float* BON = (const float*)(S + S_BON);
  const int lane = threadIdx.x & 63;
  const int gw = blockIdx.x * 4 + (threadIdx.x >> 6), stride = gridDim.x * 4;
  const int c = lane * 16, head = lane >> 2;
  for (int row = gw; row < nrows; row += stride) {
    float y[16], sum = 0.f;
#pragma unroll
    for (int hh = 0; hh < 2; ++hh) {
      const bf16x8 a = *(const bf16x8*)(Y0 + (size_t)row * D + c + hh * 8);
      const bf16x8 bq = *(const bf16x8*)(Y1 + (size_t)row * D + c + hh * 8);
#pragma unroll
      for (int e = 0; e < 8; ++e) { y[hh * 8 + e] = bf2f(a[e]) + bf2f(bq[e]); sum += y[hh * 8 + e]; }
    }
    sum = red4(sum);
    const float mu = sum * (1.0f / 64.0f);
    float var = 0.f;
#pragma unroll
    for (int e = 0; e < 16; ++e) { const float dlt = y[e] - mu; var += dlt * dlt; }
    var = red4(var) * (1.0f / 64.0f);
    const float rstd = rsqrtf(var + 64e-5f);
    const float bon = BON[(size_t)row * 16 + head] + BON[(size_t)MTOT * 16 + (size_t)row * 16 + head];
#pragma unroll
    for (int hh = 0; hh < 2; ++hh) {
      const bf16x8 v = *(const bf16x8*)(V + (size_t)row * D + c + hh * 8);
      const bf16x8 g = *(const bf16x8*)(Gb + (size_t)row * D + c + hh * 8);
      float lw[8], lbv[8];
      *(float4*)(lw) = *(const float4*)(p.in[I_LNW] + c + hh * 8); *(float4*)(lw + 4) = *(const float4*)(p.in[I_LNW] + c + hh * 8 + 4);
      *(float4*)(lbv) = *(const float4*)(p.in[I_LNB] + c + hh * 8); *(float4*)(lbv + 4) = *(const float4*)(p.in[I_LNB] + c + hh * 8 + 4);
      bf16x8 out;
#pragma unroll
      for (int e = 0; e < 8; ++e) {
        const float yn = (y[hh * 8 + e] - mu) * rstd * lw[e] + lbv[e];
        out[e] = f2bf((yn + bon * bf2f(v[e])) * bf2f(g[e]));
      }
      *(bf16x8*)(Y0 + (size_t)row * D + c + hh * 8) = out;
    }
  }
}

constexpr int NPHASE = 30;

DEV void run_phase(const Params& p, int ph, char* smem) {
  char* S = p.ws + OFF_S;
  char* W = p.ws + OFF_W;
  float* X = (float*)(p.ws + OFF_X);
  const float* MOD = (const float*)(p.ws + OFF_MOD);
  u16* H = (u16*)(S + S_H);
  if (ph == 0) { phase_prep(p, 0, smem); return; }
  if (ph == 13) { phase_prep(p, 1, smem); return; }
  if (ph == 29) { phase_final(p); return; }
  const int layer = ph >= 14 ? 1 : 0;
  int q = layer ? ph - 14 : ph - 1;
  if (layer == 0 && q == 5) { phase_xbc_conv(p, MTOT); return; }
  if (layer == 0 && q > 5) q -= 1;
  if (layer == 1 && q >= 4 && q <= 7) {
    u16* XA0 = (u16*)(S + S_Y1);
    u16* XA1 = (u16*)(S + S_G);
    if (q == 4) { phase_mix(p, 0, XA0, 2, XA1, MTOT); return; }
    if (q == 5) {
      gemm_tiles(smem, (const u16*)(W + W_R), D, D, MTOT / 128, 16, 0, ATwo{XA0, XA1},
                 EpOdd{(u16*)(S + S_R), (u16*)(S + S_LORA)});
      return;
    }
    if (q == 6) { phase_mix(p, 3, XA0, 0, nullptr, MTOT); return; }
    gemm_tiles(smem, (const u16*)(W + W_V), D, D, MTOT / 128, 8, 0, APlain{XA0, D}, EpStore{(u16*)(S + S_V), D, D, 0, 0});
    gemm_tiles<AShift, EpLora, false>(smem, (const u16*)(W + W_W1), D, D, MTOT / 128, 3, 136, AShift{H, p.in[I_XMIX], 24},
               EpLora{(u16*)(S + S_LORA)});
    return;
  }
  if (layer == 1 && q > 7) q -= 3;
  const float* modl = MOD + (size_t)layer * 5 * 9216;
  const float* ng = p.in[I_NORMG] + (size_t)layer * 3 * D;
  const bool first = (layer == 0);
  const float* xin_lat = X; const float* xin_ctx = X + (size_t)MLAT * D;
  if (q == 0) {
    if (first) phase_norm(p, p.in[I_X], p.in[I_CTX], ng, modl, 0, MTOT);
    else phase_norm(p, xin_lat, xin_ctx, ng, modl, 0, MTOT, 0, 8, 0.5f, xin_lat, xin_ctx, MOD);

    return;
  }
  if (q == 1) {
    gemm256(smem, (const u16*)(W + W_WI0), D, D, MTOT / 256, 44, APlain{H, D}, EpSwiglu{(u16*)(S + S_ACT)});
    return;
  }
  if (q == 2) {
    if (first)
      gemm_tiles<APlain, EpResid, true, false>(smem, (const u16*)(W + W_WO0), FF, FF, MTOT / 128, 8, 0, APlain{(const u16*)(S + S_ACT), FF},
                 EpResid{p.in[I_X], p.in[I_CTX], X, modl, 2, 0.5f}, (float*)(S + S_PART));
    else
      gemm_tiles<APlain, EpResid, true, false>(smem, (const u16*)(W + W_WO0), FF, FF, MTOT / 128, 8, 0, APlain{(const u16*)(S + S_ACT), FF},
                 EpResid{xin_lat, xin_ctx, X, modl, 2, 0.5f}, (float*)(S + S_PART));
    return;
  }
  if (q == 3) {
    if (first) phase_norm(p, xin_lat, xin_ctx, ng + D, modl, 1, MTOT, 0, 2, 0.5f, p.in[I_X], p.in[I_CTX], modl);
    else phase_norm(p, xin_lat, xin_ctx, ng + D, modl, 1, MTOT, 0, 2, 0.5f, xin_lat, xin_ctx, modl);
    return;
  }
  if (layer == 0) {
    if (q == 4) {
      gemm_tiles(smem, (const u16*)(W + W_IN), D, D, MTOT / 128, 33, 0, APlain{H, D},
                 EpEvenIn{(u16*)(S + S_P), (const float*)(p.ws + OFF_LBT)});
      return;
    }
    if (q == 5) {
      for (int u = blockIdx.x; u < 256; u += gridDim.x) {
        if (u < 128) hgrn_chunk_unit(p, u, smem);
        else ssd_chunk_unit(p, u - 128, smem);
      }
      return;
    }
    if (q == 6) { phase_even_finish(p, MTOT); return; }
    if (q == 7) {
      gemm_tiles<APlain, EpResid, true, false>(smem, (const u16*)(W + W_OUT), D, D, MTOT / 128, 8, 0, APlain{H, D},
                 EpResid{xin_lat, xin_ctx, X, modl, 5, 1.0f}, (float*)(S + S_PART));
      return;
    }
    if (q == 8) { phase_norm(p, xin_lat, xin_ctx, ng + 2 * D, modl, 2, MTOT, 0, 5, 1.0f, xin_lat, xin_ctx, modl); return; }
    if (q == 9) {
      gemm256(smem, (const u16*)(W + W_WI1), D, D, MTOT / 256, 44, APlain{H, D}, EpSwiglu{(u16*)(S + S_ACT)});
      return;
    }
    if (q == 10) {
      gemm_tiles<APlain, EpResid, true, false>(smem, (const u16*)(W + W_WO1), FF, FF, MTOT / 128, 8, 0, APlain{(const u16*)(S + S_ACT), FF},
                 EpResid{xin_lat, xin_ctx, X, modl, 8, 0.5f}, (float*)(S + S_PART));
      return;
    }
  } else {
    if (q == 4) {
      gemm_tiles<AShift, EpOdd, false>(smem, (const u16*)(W + W_R), D, D, MTOT / 128, 27, 0, AShift{H, p.in[I_XMIX], 0},
                 EpOdd{(u16*)(S + S_R), (u16*)(S + S_LORA)});
      return;
    }
    if (q == 5) {
      for (int u = blockIdx.x; u < 256; u += gridDim.x) odd_scan_unit(p, u, smem);
      return;
    }
    if (q == 6) {
      gemm_tiles(smem, (const u16*)(W + W_G2), 128, 128, MLAT / 128, 8, 0, APlain{(const u16*)(S + S_LORA) + 256, LLD},
                 EpStore{(u16*)(S + S_G), D, D, 0, 0});
      return;
    }
    if (q == 7) { phase_odd_finish(p, MLAT); return; }
    if (q == 8) {
      gemm256(smem, (const u16*)(W + W_O), D, D, MLAT / 256, 8, APlain{H, D},
              EpResid{xin_lat, xin_ctx, X, modl, 5, 1.0f});
      return;
    }
    if (q == 9) { phase_norm(p, xin_lat, xin_ctx, ng + 2 * D, modl, 2, MLAT); return; }
    if (q == 10) {
      gemm256(smem, (const u16*)(W + W_WI1), D, D, MLAT / 256, 44, APlain{H, D}, EpSwiglu{(u16*)(S + S_ACT)});
      return;
    }
    if (q == 11) {
      gemm256(smem, (const u16*)(W + W_WO1), FF, FF, MLAT / 256, 8, APlain{(const u16*)(S + S_ACT), FF},
              EpResid{xin_lat, xin_ctx, X, modl, 8, 0.5f});
      return;
    }
  }
}

__global__ void __launch_bounds__(256, 2) mega_kernel(Params p, int ph_lo, int ph_hi) {
  __shared__ __attribute__((aligned(16))) char smem[65536];
  cg::grid_group grid = cg::this_grid();
  XcdBarrier gb = xcd_barrier_post((unsigned*)(p.ws + OFF_BAR));
  if (ph_hi > 1000) grid.sync();
#ifdef PH_ONLY
  run_phase(p, PH_ONLY, smem);
  if (ph_lo < 0) grid.sync();
#else
#ifndef PROBE_DUP
#define PROBE_DUP -1
#endif
#define PHASE(k) if (ph_lo <= (k) && (k) < ph_hi) { run_phase(p, (k), smem); if ((k) == PROBE_DUP) { __syncthreads(); run_phase(p, (k), smem); } if ((k) + 1 < ph_hi) xcd_barrier(gb); }
  PHASE(0) PHASE(1) PHASE(2) PHASE(3) PHASE(4) PHASE(5) PHASE(6) PHASE(7) PHASE(8) PHASE(9) PHASE(10) PHASE(11) PHASE(12)
  PHASE(13) PHASE(14) PHASE(15) PHASE(16) PHASE(17) PHASE(18) PHASE(19) PHASE(20) PHASE(21) PHASE(22) PHASE(23) PHASE(24) PHASE(25) PHASE(26) PHASE(27) PHASE(28) PHASE(29)
#endif
}

#ifndef N_SPLIT
#define N_SPLIT 0
#endif

extern "C" void kernel_launch(void* const* d_in, const int* in_sizes, int n_in, void* d_out, int out_size, void* d_ws,
                              size_t ws_size, hipStream_t stream) {
  static int grid_blocks = 0;
  if (!grid_blocks) {
    int dev = 0, cus = 0, per_cu = 0;
    hipGetDevice(&dev);
    hipDeviceGetAttribute(&cus, hipDeviceAttributeMultiprocessorCount, dev);
    hipOccupancyMaxActiveBlocksPerMultiprocessor(&per_cu, mega_kernel, 256, 0);
    if (per_cu > 2) per_cu = 2;
    if (per_cu < 1) per_cu = 1;
    grid_blocks = cus * per_cu;
  }
  Params p{};
  for (int i = 0; i < 38; ++i) p.in[i] = (const float*)d_in[i];
  p.out = (float*)d_out;
  p.ws = (char*)d_ws;
#if N_SPLIT
  for (int ph = 0; ph < NPHASE; ++ph) {
    int lo = ph, hi = ph + 1;
    void* args[] = {&p, &lo, &hi};
    hipError_t e = hipLaunchCooperativeKernel((void*)mega_kernel, dim3(grid_blocks), dim3(256), args, 0, stream);
    if (e != hipSuccess) fprintf(stderr, "cooperative launch failed: %s (grid %d)\n", hipGetErrorString(e), grid_blocks);
  }
#else
  hipMemsetAsync((char*)d_ws + OFF_BAR, 0, XCD_BAR_WORDS * 4, stream);
  int lo = 0, hi = NPHASE;
  void* args[] = {&p, &lo, &hi};
  hipError_t e = hipLaunchCooperativeKernel((void*)mega_kernel, dim3(grid_blocks), dim3(256), args, 0, stream);
  if (e != hipSuccess) fprintf(stderr, "cooperative launch failed: %s (grid %d)\n", hipGetErrorString(e), grid_blocks);
#endif
}
```
